# Optimizing an MI355X kernel written in HIP

```python
import math
import jax, jax.numpy as jnp
from jax import lax
import numpy as np

D_MODEL = 2048
BATCH = 4
SEQ = 4096
DEPTH = 1

MIX_WIDTH = D_MODEL
ATTN_WIDTH = MIX_WIDTH // 2
CONV_WIDTH = MIX_WIDTH - ATTN_WIDTH
HEAD_DIM = 128
N_ATTN_HEADS = ATTN_WIDTH // HEAD_DIM
N_CONV_GROUPS = CONV_WIDTH // HEAD_DIM
CONV_K = 3
DILATED_PATTERNS = ((128, 1), (512, 4), (2048, 16))
BLOCK = 128
IN_COLS = 3 * ATTN_WIDTH + 3 * CONV_WIDTH
MEM_LEN = 256
N_MEM_HEADS = 4
MEM_HEAD_DIM = D_MODEL // N_MEM_HEADS
N_EXPERTS = 64
TOP_K = 8
N_GROUPS = 8
TOPK_GROUPS = 4
EXPERT_FF = 512
SHARED_FF = 512
ROUTED_SCALE = 2.5
EXPERT_BLOCK = 128
LN_EPS = 1e-5
RMS_EPS = 1e-6
ALPHA = (2.0 * DEPTH) ** 0.25
BETA = (8.0 * DEPTH) ** -0.25

kernel_name = "hybrid_dilated_conv_moe_deepnorm"


def layer_norm(x, g, b):
    xf = x.astype(jnp.float32)
    mu = jnp.mean(xf, -1, keepdims=True)
    var = jnp.mean(jnp.square(xf - mu), -1, keepdims=True)
    return ((xf - mu) * lax.rsqrt(var + LN_EPS) * g + b).astype(x.dtype)


def rms_norm(x, g):
    xf = x.astype(jnp.float32)
    return (xf * lax.rsqrt(jnp.mean(jnp.square(xf), -1, keepdims=True) + RMS_EPS) * g).astype(x.dtype)


def dilated_branch(q, k, v, window, dilation):
    Bsz, S, H, Dh = q.shape
    n_back = window // dilation
    L = S // dilation
    nb = -(-L // BLOCK)
    Lp = nb * BLOCK

    def sub(t):
        return t.reshape(Bsz, L, dilation, H, Dh)

    qs = jnp.pad(sub(q), ((0, 0), (0, Lp - L), (0, 0), (0, 0), (0, 0)))
    qs = qs.reshape(Bsz, nb, BLOCK, dilation, H, Dh)

    def band(t):
        tp = jnp.pad(sub(t), ((0, 0), (BLOCK, Lp - L), (0, 0), (0, 0), (0, 0)))
        tp = tp.reshape(Bsz, nb + 1, BLOCK, dilation, H, Dh)
        return jnp.concatenate([tp[:, :-1], tp[:, 1:]], axis=2)

    kb, vb = band(k), band(v)
    s = jnp.einsum('bnqrhe,bnkrhe->bnrhqk', qs, kb).astype(jnp.float32) * (Dh ** -0.5)
    qi = jnp.arange(nb)[:, None, None] * BLOCK + jnp.arange(BLOCK)[None, :, None]
    ki = jnp.arange(nb)[:, None, None] * BLOCK - BLOCK + jnp.arange(2 * BLOCK)[None, None, :]
    dist = qi - ki
    valid = (dist >= 0) & (dist <= n_back) & (ki >= 0)
    s = jnp.where(valid[None, :, None, None], s, -jnp.inf)
    m = jnp.max(s, -1, keepdims=True)
    p = jnp.exp(s - m)
    l = jnp.sum(p, -1, keepdims=True)
    o = jnp.einsum('bnrhqk,bnkrhe->bnqrhe', (p / l).astype(v.dtype), vb)
    lse = (m + jnp.log(l))[..., 0]
    o = o.reshape(Bsz, Lp, dilation, H, Dh)[:, :L].reshape(Bsz, S, H, Dh)
    lse = jnp.transpose(lse, (0, 1, 4, 2, 3)).reshape(Bsz, Lp, dilation, H)[:, :L].reshape(Bsz, S, H)
    return o, lse


def short_gated_conv(b_gate, c_gate, h, conv_w):
    S = h.shape[1]
    z = c_gate * h
    zp = jnp.pad(z, ((0, 0), (CONV_K - 1, 0), (0, 0)))
    y = conv_w[0] * zp[:, 0:S] + conv_w[1] * zp[:, 1:S + 1] + conv_w[2] * zp[:, 2:S + 2]
    return b_gate * y


def hybrid_mixer(x, w_in, conv_w, g_attn_out, g_conv_out, w_out):
    Bsz, S, _ = x.shape
    proj = x @ w_in
    A, C = ATTN_WIDTH, CONV_WIDTH
    q, k, v, b_gate, c_gate, h = jnp.split(proj, [A, 2 * A, 3 * A, 3 * A + C, 3 * A + 2 * C], axis=-1)
    q = q.reshape(Bsz, S, N_ATTN_HEADS, HEAD_DIM)
    k = k.reshape(Bsz, S, N_ATTN_HEADS, HEAD_DIM)
    v = v.reshape(Bsz, S, N_ATTN_HEADS, HEAD_DIM)
    outs, lses = [], []
    for window, dilation in DILATED_PATTERNS:
        o_i, lse_i = dilated_branch(q, k, v, window, dilation)
        outs.append(o_i)
        lses.append(lse_i)
    wts = jax.nn.softmax(jnp.stack(lses, 0), axis=0).astype(x.dtype)
    attn = jnp.einsum('gbsh,gbshe->bshe', wts, jnp.stack(outs, 0)).reshape(Bsz, S, A)
    conv = short_gated_conv(b_gate, c_gate, h, conv_w)
    mixed = jnp.concatenate([rms_norm(attn, g_attn_out), rms_norm(conv, g_conv_out)], axis=-1)
    return mixed @ w_out


def memory_cross_attention(x, mem, w_q_mem, w_kv_mem, w_o_mem):
    Bsz, S, D = x.shape
    M = mem.shape[1]
    q = (x @ w_q_mem).reshape(Bsz, S, N_MEM_HEADS, MEM_HEAD_DIM)
    k, v = jnp.split(mem @ w_kv_mem, 2, axis=-1)
    k = k.reshape(Bsz, M, N_MEM_HEADS, MEM_HEAD_DIM)
    v = v.reshape(Bsz, M, N_MEM_HEADS, MEM_HEAD_DIM)
    s = jnp.einsum('bshe,bmhe->bhsm', q, k).astype(jnp.float32) * (MEM_HEAD_DIM ** -0.5)
    p = jax.nn.softmax(s, axis=-1).astype(x.dtype)
    o = jnp.einsum('bhsm,bmhe->bshe', p, v).reshape(Bsz, S, D)
    return o @ w_o_mem


def route(xf, w_router, router_bias):
    N = xf.shape[0]
    scores = jax.nn.sigmoid((xf @ w_router).astype(jnp.float32))
    choice = scores + router_bias.astype(jnp.float32)
    grp = choice.reshape(N, N_GROUPS, N_EXPERTS // N_GROUPS)
    grp_score = jnp.sum(lax.top_k(grp, 2)[0], axis=-1)
    _, top_g = lax.top_k(grp_score, TOPK_GROUPS)
    gmask = jnp.any(top_g[..., None] == jnp.arange(N_GROUPS)[None, None, :], axis=1)
    emask = jnp.repeat(gmask, N_EXPERTS // N_GROUPS, axis=-1)
    _, idx = lax.top_k(jnp.where(emask, choice, -jnp.inf), TOP_K)
    w = jnp.take_along_axis(scores, idx, axis=-1)
    gates = w / jnp.sum(w, -1, keepdims=True) * ROUTED_SCALE
    return idx, gates


def routed_experts(xf, idx, gates, w_gate, w_up, w_down):
    N, D = xf.shape
    A = N * TOP_K
    e_flat = idx.reshape(A)
    tok_flat = jnp.repeat(jnp.arange(N, dtype=jnp.int32), TOP_K)
    g_flat = gates.reshape(A).astype(xf.dtype)
    order = jnp.argsort(e_flat)
    e_sorted = e_flat[order]
    counts = jnp.zeros((N_EXPERTS,), jnp.int32).at[e_flat].add(1)
    padded = (counts + EXPERT_BLOCK - 1) // EXPERT_BLOCK * EXPERT_BLOCK
    start = jnp.cumsum(counts) - counts
    pend = jnp.cumsum(padded)
    pstart = pend - padded
    dest = pstart[e_sorted] + jnp.arange(A, dtype=jnp.int32) - start[e_sorted]
    n_blocks = -(-A // EXPERT_BLOCK) + N_EXPERTS
    R = n_blocks * EXPERT_BLOCK
    row_tok = jnp.full((R,), N, jnp.int32).at[dest].set(tok_flat[order])
    row_gate = jnp.zeros((R,), xf.dtype).at[dest].set(g_flat[order])
    block_start = jnp.arange(n_blocks, dtype=jnp.int32) * EXPERT_BLOCK
    block_exp = jnp.minimum(jnp.searchsorted(pend, block_start, side='right'), N_EXPERTS - 1)
    x_pad = jnp.concatenate([xf, jnp.zeros((1, D), xf.dtype)], axis=0)

    def run_block(args):
        tok, gate, e = args
        xb = x_pad[tok]
        hb = jax.nn.silu(xb @ w_gate[e]) * (xb @ w_up[e])
        return (hb @ w_down[e]) * gate[:, None]

    yb = lax.map(run_block, (row_tok.reshape(n_blocks, EXPERT_BLOCK),
                             row_gate.reshape(n_blocks, EXPERT_BLOCK), block_exp))
    return jax.ops.segment_sum(yb.reshape(R, D), row_tok, num_segments=N + 1)[:N]


def moe_ffn(x, w_router, router_bias, w_gate, w_up, w_down, ws_gate, ws_up, ws_down):
    Bsz, S, D = x.shape
    xf = x.reshape(Bsz * S, D)
    idx, gates = route(xf, w_router, router_bias)
    routed = routed_experts(xf, idx, gates, w_gate, w_up, w_down)
    shared = (jax.nn.silu(xf @ ws_gate) * (xf @ ws_up)) @ ws_down
    return (routed + shared).reshape(Bsz, S, D)


def setup_inputs(seed: int = 0) -> dict:
    key = jax.random.key(seed)
    ks = jax.random.split(key, 24)
    f32 = jnp.float32
    nrm = lambda k, shape, scale: jax.random.normal(k, shape, f32) * scale
    L = DEPTH
    return {
        "x": nrm(ks[0], (BATCH, SEQ, D_MODEL), 1.0),
        "mem": nrm(ks[1], (BATCH, MEM_LEN, D_MODEL), 1.0),
        "w_in": nrm(ks[2], (L, D_MODEL, IN_COLS), D_MODEL ** -0.5),
        "conv_w": nrm(ks[3], (L, CONV_K, CONV_WIDTH), CONV_K ** -0.5),
        "g_attn_out": 1.0 + nrm(ks[4], (L, ATTN_WIDTH), 0.02),
        "g_conv_out": 1.0 + nrm(ks[5], (L, CONV_WIDTH), 0.02),
        "w_out": nrm(ks[6], (L, MIX_WIDTH, D_MODEL), MIX_WIDTH ** -0.5 * BETA),
        "ln1_g": 1.0 + nrm(ks[7], (L, D_MODEL), 0.02),
        "ln1_b": nrm(ks[8], (L, D_MODEL), 0.02),
        "w_q_mem": nrm(ks[9], (L, D_MODEL, D_MODEL), D_MODEL ** -0.5),
        "w_kv_mem": nrm(ks[10], (L, D_MODEL, 2 * D_MODEL), D_MODEL ** -0.5),
        "w_o_mem": nrm(ks[11], (L, D_MODEL, D_MODEL), D_MODEL ** -0.5 * BETA),
        "ln2_g": 1.0 + nrm(ks[12], (L, D_MODEL), 0.02),
        "ln2_b": nrm(ks[13], (L, D_MODEL), 0.02),
        "w_router": nrm(ks[14], (L, D_MODEL, N_EXPERTS), D_MODEL ** -0.5),
        "router_bias": nrm(ks[15], (L, N_EXPERTS), 0.01),
        "w_gate": nrm(ks[16], (L, N_EXPERTS, D_MODEL, EXPERT_FF), D_MODEL ** -0.5),
        "w_up": nrm(ks[17], (L, N_EXPERTS, D_MODEL, EXPERT_FF), D_MODEL ** -0.5),
        "w_down": nrm(ks[18], (L, N_EXPERTS, EXPERT_FF, D_MODEL), EXPERT_FF ** -0.5 * BETA),
        "ws_gate": nrm(ks[19], (L, D_MODEL, SHARED_FF), D_MODEL ** -0.5),
        "ws_up": nrm(ks[20], (L, D_MODEL, SHARED_FF), D_MODEL ** -0.5),
        "ws_down": nrm(ks[21], (L, SHARED_FF, D_MODEL), SHARED_FF ** -0.5 * BETA),
        "ln3_g": 1.0 + nrm(ks[22], (L, D_MODEL), 0.02),
        "ln3_b": nrm(ks[23], (L, D_MODEL), 0.02),
    }


def reference(x, mem, w_in, conv_w, g_attn_out, g_conv_out, w_out, ln1_g, ln1_b,
              w_q_mem, w_kv_mem, w_o_mem, ln2_g, ln2_b, w_router, router_bias,
              w_gate, w_up, w_down, ws_gate, ws_up, ws_down, ln3_g, ln3_b):
    for l in range(DEPTH):
        y = hybrid_mixer(x, w_in[l], conv_w[l], g_attn_out[l], g_conv_out[l], w_out[l])
        x = layer_norm(ALPHA * x + y, ln1_g[l], ln1_b[l])
        y = memory_cross_attention(x, mem, w_q_mem[l], w_kv_mem[l], w_o_mem[l])
        x = layer_norm(ALPHA * x + y, ln2_g[l], ln2_b[l])
        y = moe_ffn(x, w_router[l], router_bias[l], w_gate[l], w_up[l], w_down[l],
                    ws_gate[l], ws_up[l], ws_down[l])
        x = layer_norm(ALPHA * x + y, ln3_g[l], ln3_b[l])
    return x
```

```cpp
#include <hip/hip_runtime.h>
namespace nv {
constexpr int NTOK = 16384, DM = 2048, SEQL = 4096, NB = 4, INC = 6144, AW = 1024, HD = 128, NH = 8;
constexpr int MEML = 256, NMH = 4, MHD = 512, NE = 64, TOPK = 8, FF = 512, CAP = 16384;
constexpr float LN_EPS = 1e-5f, RMS_EPS = 1e-6f;
#define NV_ALPHA 1.189207115002721f

struct GemmAcc { float c[4][4]; };
template <class ARow>
__device__ __forceinline__ void gemm_core(GemmAcc& acc, const ARow& arow, int m0, const float* B, int ldb, int n0, int N, int K, float* As, float* Bs) {
    const int tid = threadIdx.x, tx = tid & 15, ty = tid >> 4;
#pragma unroll
    for (int i = 0; i < 4; ++i)
#pragma unroll
        for (int j = 0; j < 4; ++j) acc.c[i][j] = 0.f;
    const int ar = tid >> 2, ak = (tid & 3) * 4;
    const float* ap = arow(m0 + ar);
    const int bk = tid >> 4, bn = (tid & 15) * 4;
    for (int k0 = 0; k0 < K; k0 += 16) {
        float4 av = ap ? *(const float4*)(ap + k0 + ak) : make_float4(0.f, 0.f, 0.f, 0.f);
        float4 bv = (n0 + bn < N) ? *(const float4*)(B + (size_t)(k0 + bk) * ldb + n0 + bn) : make_float4(0.f, 0.f, 0.f, 0.f);
        __syncthreads();
        As[(ak + 0) * 68 + ar] = av.x; As[(ak + 1) * 68 + ar] = av.y; As[(ak + 2) * 68 + ar] = av.z; As[(ak + 3) * 68 + ar] = av.w;
        *(float4*)(Bs + bk * 64 + bn) = bv;
        __syncthreads();
#pragma unroll
        for (int kk = 0; kk < 16; ++kk) {
            const float4 a4 = *(const float4*)(As + kk * 68 + ty * 4);
            const float4 b4 = *(const float4*)(Bs + kk * 64 + tx * 4);
            const float a[4] = {a4.x, a4.y, a4.z, a4.w}, b[4] = {b4.x, b4.y, b4.z, b4.w};
#pragma unroll
            for (int i = 0; i < 4; ++i)
#pragma unroll
                for (int j = 0; j < 4; ++j) acc.c[i][j] = fmaf(a[i], b[j], acc.c[i][j]);
        }
    }
}
struct RowPlain { const float* A; int lda; int M; __device__ const float* operator()(int m) const { return m < M ? A + (size_t)m * lda : nullptr; } };

__global__ void __launch_bounds__(256) k_gemm(const float* A, int lda, const float* B, int ldb, float* C, int ldc, int M, int N, int K, const float* R, float alpha, float scale) {
    __shared__ float As[16 * 68], Bs[16 * 64];
    const int m0 = blockIdx.y * 64, n0 = blockIdx.x * 64, tx = threadIdx.x & 15, ty = threadIdx.x >> 4;
    GemmAcc acc; RowPlain ar{A, lda, M};
    gemm_core(acc, ar, m0, B, ldb, n0, N, K, As, Bs);
#pragma unroll
    for (int i = 0; i < 4; ++i) { const int m = m0 + ty * 4 + i; if (m >= M) continue;
#pragma unroll
        for (int j = 0; j < 4; ++j) { const int n = n0 + tx * 4 + j; if (n >= N) continue;
            float v = acc.c[i][j] * scale; if (R) v += alpha * R[(size_t)m * ldc + n]; C[(size_t)m * ldc + n] = v; } }
}

__global__ void __launch_bounds__(64) k_dilated_attn(const float* proj, float* attn) {
    __shared__ float qs[128], sc[3][132], red[8];
    const int t = blockIdx.x >> 3, h = blockIdx.x & 7, lane = threadIdx.x;
    const int b = t / SEQL, s = t % SEQL;
    const float* q = proj + (size_t)t * INC + h * HD;
    qs[lane] = q[lane]; qs[lane + 64] = q[lane + 64];
    __syncthreads();
    float lse[3], mg[3], lg[3];
#pragma unroll
    for (int g = 0; g < 3; ++g) {
        const int d = 1 << (2 * g);
        float mloc = -INFINITY;
        for (int j = lane; j <= 128; j += 64) {
            const int pos = s - j * d; float v = -INFINITY;
            if (pos >= 0) { const float* k = proj + (size_t)(b * SEQL + pos) * INC + AW + h * HD; float a = 0.f; for (int e = 0; e < HD; ++e) a = fmaf(qs[e], k[e], a); v = a * 0.08838834764831845f; }
            sc[g][j] = v; mloc = fmaxf(mloc, v);
        }
        for (int o = 32; o >= 1; o >>= 1) mloc = fmaxf(mloc, __shfl_xor(mloc, o));
        __syncthreads();
        float l = 0.f;
        for (int j = lane; j <= 128; j += 64) { const float p = (sc[g][j] == -INFINITY) ? 0.f : expf(sc[g][j] - mloc); sc[g][j] = p; l += p; }
        for (int o = 32; o >= 1; o >>= 1) l += __shfl_xor(l, o);
        mg[g] = mloc; lg[g] = l; lse[g] = mloc + logf(l);
        __syncthreads();
    }
    const float mx = fmaxf(lse[0], fmaxf(lse[1], lse[2]));
    float w[3]; float ws = 0.f;
#pragma unroll
    for (int g = 0; g < 3; ++g) { w[g] = expf(lse[g] - mx); ws += w[g]; }
    float o0 = 0.f, o1 = 0.f;
#pragma unroll
    for (int g = 0; g < 3; ++g) {
        const int d = 1 << (2 * g); const float f = w[g] / ws / lg[g]; float a0 = 0.f, a1 = 0.f;
        for (int j = 0; j <= 128; ++j) { const int pos = s - j * d; if (pos < 0) break; const float p = sc[g][j]; const float* v = proj + (size_t)(b * SEQL + pos) * INC + 2 * AW + h * HD; a0 = fmaf(p, v[lane], a0); a1 = fmaf(p, v[lane + 64], a1); }
        o0 += f * a0; o1 += f * a1;
    }
    (void)mg; (void)red;
    attn[(size_t)t * AW + h * HD + lane] = o0; attn[(size_t)t * AW + h * HD + lane + 64] = o1;
}

__global__ void __launch_bounds__(256) k_mixer_post(const float* proj, const float* attn, const float* conv_w, const float* g_attn, const float* g_conv, float* mixed) {
    const int t = blockIdx.x, tid = threadIdx.x, s = t % SEQL;
    float a[4], c[4];
#pragma unroll
    for (int i = 0; i < 4; ++i) {
        const int col = tid * 4 + i;
        a[i] = attn[(size_t)t * AW + col];
        const float* pr = proj + (size_t)t * INC + 3 * AW;
        float y = 0.f;
        for (int tap = 0; tap < 3; ++tap) { const int back = 2 - tap; if (s - back < 0) continue; const float* pp = pr - (size_t)back * INC; y += conv_w[tap * AW + col] * (pp[AW + col] * pp[2 * AW + col]); }
        c[i] = pr[col] * y;
    }
    float sa = a[0] * a[0] + a[1] * a[1] + a[2] * a[2] + a[3] * a[3], sc_ = c[0] * c[0] + c[1] * c[1] + c[2] * c[2] + c[3] * c[3];
    __shared__ float reda[4], redc[4];
    for (int o = 32; o >= 1; o >>= 1) { sa += __shfl_xor(sa, o); sc_ += __shfl_xor(sc_, o); }
    if ((tid & 63) == 0) { reda[tid >> 6] = sa; redc[tid >> 6] = sc_; }
    __syncthreads();
    sa = reda[0] + reda[1] + reda[2] + reda[3]; sc_ = redc[0] + redc[1] + redc[2] + redc[3];
    const float ra = rsqrtf(sa / 1024.f + RMS_EPS), rc = rsqrtf(sc_ / 1024.f + RMS_EPS);
#pragma unroll
    for (int i = 0; i < 4; ++i) { const int col = tid * 4 + i; mixed[(size_t)t * DM + col] = a[i] * ra * g_attn[col]; mixed[(size_t)t * DM + AW + col] = c[i] * rc * g_conv[col]; }
}

__global__ void __launch_bounds__(256) k_layernorm(const float* in, const float* g, const float* bta, float* out) {
    __shared__ float red[8];
    const int t = blockIdx.x, tid = threadIdx.x;
    float v[8]; float s = 0.f;
#pragma unroll
    for (int i = 0; i < 8; ++i) { v[i] = in[(size_t)t * DM + tid + 256 * i]; s += v[i]; }
    for (int o = 32; o >= 1; o >>= 1) s += __shfl_xor(s, o);
    if ((tid & 63) == 0) red[tid >> 6] = s; __syncthreads();
    const float mean = (red[0] + red[1] + red[2] + red[3]) / DM; __syncthreads();
    float q = 0.f;
#pragma unroll
    for (int i = 0; i < 8; ++i) { v[i] -= mean; q += v[i] * v[i]; }
    for (int o = 32; o >= 1; o >>= 1) q += __shfl_xor(q, o);
    if ((tid & 63) == 0) red[tid >> 6] = q; __syncthreads();
    const float rstd = rsqrtf((red[0] + red[1] + red[2] + red[3]) / DM + LN_EPS);
#pragma unroll
    for (int i = 0; i < 8; ++i) { const int c = tid + 256 * i; out[(size_t)t * DM + c] = v[i] * rstd * g[c] + bta[c]; }
}

__global__ void __launch_bounds__(256) k_cross_attn(const float* qm, const float* kvm, float* om) {
    __shared__ float qs[512], ps[256], red[8];
    const int t = blockIdx.x >> 2, h = blockIdx.x & 3, tid = threadIdx.x, b = t / SEQL;
    qs[tid] = qm[(size_t)t * DM + h * MHD + tid]; qs[tid + 256] = qm[(size_t)t * DM + h * MHD + tid + 256];
    __syncthreads();
    const float* k = kvm + (size_t)(b * MEML + tid) * (2 * DM) + h * MHD;
    float a = 0.f; for (int e = 0; e < MHD; e += 4) { const float4 kv = *(const float4*)(k + e); a = fmaf(qs[e], kv.x, a); a = fmaf(qs[e + 1], kv.y, a); a = fmaf(qs[e + 2], kv.z, a); a = fmaf(qs[e + 3], kv.w, a); }
    a *= 0.04419417382415922f;
    float m = a; for (int o = 32; o >= 1; o >>= 1) m = fmaxf(m, __shfl_xor(m, o));
    if ((tid & 63) == 0) red[tid >> 6] = m; __syncthreads();
    m = fmaxf(fmaxf(red[0], red[1]), fmaxf(red[2], red[3])); __syncthreads();
    const float p = expf(a - m); float l = p; for (int o = 32; o >= 1; o >>= 1) l += __shfl_xor(l, o);
    if ((tid & 63) == 0) red[tid >> 6] = l; ps[tid] = p; __syncthreads();
    l = red[0] + red[1] + red[2] + red[3];
    float o0 = 0.f, o1 = 0.f;
    for (int j = 0; j < MEML; ++j) { const float* v = kvm + (size_t)(b * MEML + j) * (2 * DM) + DM + h * MHD; o0 = fmaf(ps[j], v[tid], o0); o1 = fmaf(ps[j], v[tid + 256], o1); }
    om[(size_t)t * DM + h * MHD + tid] = o0 / l; om[(size_t)t * DM + h * MHD + tid + 256] = o1 / l;
}

__global__ void __launch_bounds__(64) k_route(const float* logits, const float* bias, int* cnt, int* list_tok, int* list_slot, float* gates) {
    __shared__ float scs[64 * 65], chs[64 * 65];
    const int t = blockIdx.x * 64 + threadIdx.x;
    float* sc = scs + threadIdx.x * 65; float* ch = chs + threadIdx.x * 65;
    for (int e = 0; e < 64; ++e) { const float z = logits[(size_t)t * 64 + e]; const float sv = 1.f / (1.f + expf(-z)); sc[e] = sv; ch[e] = sv + bias[e]; }
    unsigned gsel = 0u;
    {
        float gs0, gs1, gs2, gs3, gs4, gs5, gs6, gs7;
#define NV_GS(g, dst) { float m1 = -INFINITY, m2 = -INFINITY; for (int i = 0; i < 8; ++i) { const float v = ch[(g) * 8 + i]; if (v > m1) { m2 = m1; m1 = v; } else if (v > m2) m2 = v; } dst = m1 + m2; }
        NV_GS(0, gs0) NV_GS(1, gs1) NV_GS(2, gs2) NV_GS(3, gs3) NV_GS(4, gs4) NV_GS(5, gs5) NV_GS(6, gs6) NV_GS(7, gs7)
#undef NV_GS
        for (int r = 0; r < 4; ++r) { int best = 0; float bv = -INFINITY;
#define NV_PK(g, v) if (!((gsel >> (g)) & 1u) && (v) > bv) { bv = (v); best = (g); }
            NV_PK(0, gs0) NV_PK(1, gs1) NV_PK(2, gs2) NV_PK(3, gs3) NV_PK(4, gs4) NV_PK(5, gs5) NV_PK(6, gs6) NV_PK(7, gs7)
#undef NV_PK
            gsel |= 1u << best; }
    }
    unsigned long long used = 0ull; float wsum = 0.f;
    for (int r = 0; r < 8; ++r) { int best = 0; float bv = -INFINITY; for (int e = 0; e < 64; ++e) if (((gsel >> (e >> 3)) & 1u) && !((used >> e) & 1ull) && ch[e] > bv) { bv = ch[e]; best = e; } used |= 1ull << best; wsum += sc[best];
        ((int*)gates)[t * 8 + r] = best; }
    for (int r = 0; r < 8; ++r) { const int e = ((int*)gates)[t * 8 + r]; const int pos = atomicAdd(&cnt[e], 1); list_tok[e * CAP + pos] = t; list_slot[e * CAP + pos] = t * 8 + r; gates[t * 8 + r] = sc[e] / wsum * 2.5f; }
}

struct RowGather { const float* X; const int* tok; int cnt; __device__ const float* operator()(int m) const { return m < cnt ? X + (size_t)tok[m] * DM : nullptr; } };
__global__ void __launch_bounds__(256) k_moe1(const float* x2, const float* wg, const float* wu, const int* cnt, const int* list_tok, const int* list_slot, float* H) {
    __shared__ float As[16 * 68], Bs[16 * 64];
    const int e = blockIdx.z, m0 = blockIdx.y * 64, n0 = blockIdx.x * 64, c = cnt[e]; if (m0 >= c) return;
    const int tx = threadIdx.x & 15, ty = threadIdx.x >> 4;
    RowGather ar{x2, list_tok + e * CAP, c};
    GemmAcc g, u;
    gemm_core(g, ar, m0, wg + (size_t)e * DM * FF, FF, n0, FF, DM, As, Bs);
    __syncthreads();
    gemm_core(u, ar, m0, wu + (size_t)e * DM * FF, FF, n0, FF, DM, As, Bs);
#pragma unroll
    for (int i = 0; i < 4; ++i) { const int m = m0 + ty * 4 + i; if (m >= c) continue; const int slot = list_slot[e * CAP + m];
#pragma unroll
        for (int j = 0; j < 4; ++j) { const float gv = g.c[i][j]; H[(size_t)slot * FF + n0 + tx * 4 + j] = gv / (1.f + expf(-gv)) * u.c[i][j]; } }
}
struct RowSlot { const float* H; const int* slot; int cnt; __device__ const float* operator()(int m) const { return m < cnt ? H + (size_t)slot[m] * FF : nullptr; } };
__global__ void __launch_bounds__(256) k_moe2(const float* H, const float* wd, const int* cnt, const int* list_tok, const int* list_slot, const float* gates, float* accum) {
    __shared__ float As[16 * 68], Bs[16 * 64];
    const int e = blockIdx.z, m0 = blockIdx.y * 64, n0 = blockIdx.x * 64, c = cnt[e]; if (m0 >= c) return;
    const int tx = threadIdx.x & 15, ty = threadIdx.x >> 4;
    RowSlot ar{H, list_slot + e * CAP, c};
    GemmAcc y;
    gemm_core(y, ar, m0, wd + (size_t)e * FF * DM, DM, n0, DM, FF, As, Bs);
#pragma unroll
    for (int i = 0; i < 4; ++i) { const int m = m0 + ty * 4 + i; if (m >= c) continue; const int slot = list_slot[e * CAP + m], tok = list_tok[e * CAP + m]; const float gt = gates[slot];
#pragma unroll
        for (int j = 0; j < 4; ++j) atomicAdd(&accum[(size_t)tok * DM + n0 + tx * 4 + j], gt * y.c[i][j]); }
}
__global__ void k_silu_mul(const float* g, const float* u, float* h, size_t n) { for (size_t i = (size_t)blockIdx.x * blockDim.x + threadIdx.x; i < n; i += (size_t)gridDim.x * blockDim.x) { const float gv = g[i]; h[i] = gv / (1.f + expf(-gv)) * u[i]; } }
__global__ void k_axpy(const float* x, float* acc, float alpha, size_t n) { for (size_t i = (size_t)blockIdx.x * blockDim.x + threadIdx.x; i < n; i += (size_t)gridDim.x * blockDim.x) acc[i] += alpha * x[i]; }

struct In { const float *x, *mem, *w_in, *conv_w, *g_attn, *g_conv, *w_out, *ln1g, *ln1b, *wq, *wkv, *wo, *ln2g, *ln2b, *wr, *rb, *wg, *wu, *wd, *wsg, *wsu, *wsd, *ln3g, *ln3b; };
inline In make_in(void* const* d) { In p; const float** f = (const float**)&p; for (int i = 0; i < 24; ++i) f[i] = (const float*)d[i]; return p; }

constexpr size_t MB = 1u << 20;
enum { ST_INPROJ = 0, ST_ATTN, ST_MIXPOST, ST_OUTPROJ, ST_LN1, ST_QKV, ST_XATTN, ST_OPROJ, ST_LN2, ST_ROUTE, ST_MOE, ST_LN3, ST_END };
struct Bufs { float *proj, *attn, *mixed, *t, *x1, *qm, *kvm, *om, *x2, *logits, *H, *gs, *us, *hs, *acc, *gates; int *cnt, *ltok, *lslot; };
inline Bufs make_bufs(void* ws) {
    char* w = (char*)ws; Bufs b;
    b.proj = (float*)(w + 0); b.H = (float*)(w + 0); b.gs = (float*)(w + 272 * MB); b.us = (float*)(w + 306 * MB); b.hs = (float*)(w + 340 * MB);
    b.mixed = (float*)(w + 384 * MB); b.om = b.mixed; b.acc = b.mixed;
    b.t = (float*)(w + 512 * MB); b.attn = b.t;
    b.x1 = (float*)(w + 640 * MB);
    b.qm = (float*)(w + 768 * MB); b.x2 = b.qm;
    b.kvm = (float*)(w + 896 * MB);
    b.logits = (float*)(w + 916 * MB); b.gates = (float*)(w + 921 * MB);
    b.cnt = (int*)(w + 922 * MB); b.ltok = (int*)(w + 923 * MB); b.lslot = (int*)(w + 928 * MB);
    return b;
}
inline void run(const In& p, const Bufs& b, float* out, hipStream_t st, int lo, int hi) {
    auto gemm = [&](const float* A, int lda, const float* B, int ldb, float* C, int ldc, int M, int N, int K, const float* R, float alpha) {
        hipLaunchKernelGGL(k_gemm, dim3((N + 63) / 64, (M + 63) / 64), dim3(256), 0, st, A, lda, B, ldb, C, ldc, M, N, K, R, alpha, 1.0f); };
#define NV_IN(s) (lo <= (s) && (s) < hi)
    if (NV_IN(ST_INPROJ)) gemm(p.x, DM, p.w_in, INC, b.proj, INC, NTOK, INC, DM, nullptr, 0.f);
    if (NV_IN(ST_ATTN)) hipLaunchKernelGGL(k_dilated_attn, dim3(NTOK * 8), dim3(64), 0, st, b.proj, b.attn);
    if (NV_IN(ST_MIXPOST)) hipLaunchKernelGGL(k_mixer_post, dim3(NTOK), dim3(256), 0, st, b.proj, b.attn, p.conv_w, p.g_attn, p.g_conv, b.mixed);
    if (NV_IN(ST_OUTPROJ)) gemm(b.mixed, DM, p.w_out, DM, b.t, DM, NTOK, DM, DM, p.x, NV_ALPHA);
    if (NV_IN(ST_LN1)) hipLaunchKernelGGL(k_layernorm, dim3(NTOK), dim3(256), 0, st, b.t, p.ln1g, p.ln1b, b.x1);
    if (NV_IN(ST_QKV)) { gemm(b.x1, DM, p.wq, DM, b.qm, DM, NTOK, DM, DM, nullptr, 0.f); gemm(p.mem, DM, p.wkv, 2 * DM, b.kvm, 2 * DM, NB * MEML, 2 * DM, DM, nullptr, 0.f); }
    if (NV_IN(ST_XATTN)) hipLaunchKernelGGL(k_cross_attn, dim3(NTOK * 4), dim3(256), 0, st, b.qm, b.kvm, b.om);
    if (NV_IN(ST_OPROJ)) gemm(b.om, DM, p.wo, DM, b.t, DM, NTOK, DM, DM, b.x1, NV_ALPHA);
    if (NV_IN(ST_LN2)) hipLaunchKernelGGL(k_layernorm, dim3(NTOK), dim3(256), 0, st, b.t, p.ln2g, p.ln2b, b.x2);
    if (NV_IN(ST_ROUTE)) {
        gemm(b.x2, DM, p.wr, NE, b.logits, NE, NTOK, NE, DM, nullptr, 0.f);
        hipMemsetAsync(b.cnt, 0, 64 * sizeof(int), st);
        hipLaunchKernelGGL(k_route, dim3(NTOK / 64), dim3(64), 0, st, b.logits, p.rb, b.cnt, b.ltok, b.lslot, b.gates);
    }
    if (NV_IN(ST_MOE)) {
        hipMemsetAsync(b.acc, 0, (size_t)NTOK * DM * 4, st);
        hipLaunchKernelGGL(k_moe1, dim3(FF / 64, CAP / 64, NE), dim3(256), 0, st, b.x2, p.wg, p.wu, b.cnt, b.ltok, b.lslot, b.H);
        hipLaunchKernelGGL(k_moe2, dim3(DM / 64, CAP / 64, NE), dim3(256), 0, st, b.H, p.wd, b.cnt, b.ltok, b.lslot, b.gates, b.acc);
        gemm(b.x2, DM, p.wsg, FF, b.gs, FF, NTOK, FF, DM, nullptr, 0.f);
        gemm(b.x2, DM, p.wsu, FF, b.us, FF, NTOK, FF, DM, nullptr, 0.f);
        hipLaunchKernelGGL(k_silu_mul, dim3(2048), dim3(256), 0, st, b.gs, b.us, b.hs, (size_t)NTOK * FF);
        gemm(b.hs, FF, p.wsd, DM, b.t, DM, NTOK, DM, FF, b.x2, NV_ALPHA);
        hipLaunchKernelGGL(k_axpy, dim3(4096), dim3(256), 0, st, b.t, b.acc, 1.0f, (size_t)NTOK * DM);
    }
    if (NV_IN(ST_LN3)) hipLaunchKernelGGL(k_layernorm, dim3(NTOK), dim3(256), 0, st, b.acc, p.ln3g, p.ln3b, out);
#undef NV_IN
}
}
extern "C" void kernel_launch(void* const* d_in, const int* in_sizes, int n_in, void* d_out, int out_size, void* d_ws, size_t ws_size, hipStream_t stream) {
    nv::In p = nv::make_in(d_in); nv::Bufs b = nv::make_bufs(d_ws);
    nv::run(p, b, (float*)d_out, stream, 0, nv::ST_END);
}
```

```cpp
#include <hip/hip_runtime.h>
#include <cstdio>
#include <cstdint>
#include <cmath>
namespace pg8 {
#define PG8_LAS __attribute__((address_space(3)))
typedef unsigned short bf16_t;
typedef short bf16x8 __attribute__((ext_vector_type(8)));
typedef float f32x4 __attribute__((ext_vector_type(4)));
typedef float f32x2 __attribute__((ext_vector_type(2)));
typedef unsigned u32x4 __attribute__((ext_vector_type(4)));
constexpr int BM = 256, BK = 64, HALF = 128, HTB = HALF * BK * 2  , STAGE_BYTES = 8 * HTB, NXCD = 8, WGM = 8;

__host__ __device__ __forceinline__ int lds_byte(int r, int c) { const int st = (r >> 4) * 2 + (c >> 5), rr = r & 15, cc = c & 31, ob = rr * 64 + cc * 2; return st * 1024 + (ob ^ (((ob >> 9) & 1) << 5)); }
__host__ __device__ __forceinline__ void stage_rc(int b, int& R, int& C) { const int st = b / 1024, sb = b % 1024, swz = sb ^ (((sb >> 9) & 1) << 5); R = (st >> 1) * 16 + swz / 64; C = (st & 1) * 32 + (swz % 64) / 2; }
__host__ __device__ __forceinline__ int perm32(int rho) { const int n = rho >> 4, i = rho & 15; return 8 * (i >> 2) + 4 * n + (i & 3); }

struct Unit { int pm, pn; const char* A; const char* B; int e; int slot; };

struct DenseOrder {
    const char* A; const char* Bt; int K; int nM, nN, nwg, G, c;
    __device__ void init(const void* A_, const void* Bt_, int M, int N, int K_, int G_, int c_) { A = (const char*)A_; Bt = (const char*)Bt_; K = K_; nM = M / BM; nN = N / BM; nwg = nM * nN; G = G_; c = c_; }
    __device__ __forceinline__ bool next(int i, Unit& u) const {
        const long L = (long)i * G + c; if (L >= nwg) return false;
        int wgid = (int)L; { const int q = nwg / NXCD, r = nwg % NXCD, xcd = wgid % NXCD, off = wgid / NXCD; wgid = (xcd < r ? xcd * (q + 1) : r * (q + 1) + (xcd - r) * q) + off; }
        const int nig = WGM * nN, gid = wgid / nig, fm = gid * WGM, gsz = (nM - fm) < WGM ? (nM - fm) : WGM;
        u.pm = fm + ((wgid % nig) % gsz); u.pn = (wgid % nig) / gsz;
        u.A = A + (size_t)u.pm * BM * K * 2; u.B = Bt + (size_t)u.pn * BM * K * 2; u.e = 0; u.slot = i; return true;
    }
};

typedef __bf16 bf16x2_t __attribute__((ext_vector_type(2)));
__device__ __forceinline__ unsigned cvt_pk_bf16(float lo, float hi) { const f32x2 v = {lo, hi}; const bf16x2_t r = __builtin_convertvector(v, bf16x2_t); return __builtin_bit_cast(unsigned, r); }

struct EpiBf16 {
    static constexpr bool PERM = true;
    bf16_t* O; int ldc; int split_cols; size_t split_stride; float scale0;
    __device__ __forceinline__ void operator()(const f32x4 (&acc)[2][2][4][2], const Unit& u, int wr, int wc, int fr, int fq, PG8_LAS const int* tab) const {
        const int row0 = u.pm * BM + wr * 64 + fr; int colt = u.pn * BM; bf16_t* base = O;
        float sc = scale0; if (split_cols) { const int t = colt / split_cols; base += (size_t)t * split_stride; colt -= t * split_cols; if (t != 0) sc = 1.f; }
        const int col0 = colt + wc * 32 + 8 * fq;
#pragma unroll
        for (int ai = 0; ai < 2; ++ai)
#pragma unroll
            for (int m = 0; m < 4; ++m) { bf16_t* rowp = base + (size_t)(row0 + ai * HALF + m * 16) * ldc + col0;
#pragma unroll
                for (int bj = 0; bj < 2; ++bj) { f32x4 v0 = acc[ai][bj][m][0] * sc, v1 = acc[ai][bj][m][1] * sc;
                    u32x4 w; w.x = cvt_pk_bf16(v0[0], v0[1]); w.y = cvt_pk_bf16(v0[2], v0[3]); w.z = cvt_pk_bf16(v1[0], v1[1]); w.w = cvt_pk_bf16(v1[2], v1[3]);
                    *(u32x4*)(rowp + bj * HALF) = w; } }
    }
};
struct EpiResF32 {
    static constexpr bool PERM = false;
    float* C; const float* R; int ldc; float alpha;
    __device__ __forceinline__ void operator()(const f32x4 (&acc)[2][2][4][2], const Unit& u, int wr, int wc, int fr, int fq, PG8_LAS const int* tab) const {
        const int row0 = u.pm * BM + wr * 64 + fr, col0 = u.pn * BM + wc * 32 + 4 * fq;
#pragma unroll
        for (int ai = 0; ai < 2; ++ai)
#pragma unroll
            for (int m = 0; m < 4; ++m) { const size_t off = (size_t)(row0 + ai * HALF + m * 16) * ldc + col0;
#pragma unroll
                for (int bj = 0; bj < 2; ++bj)
#pragma unroll
                    for (int n = 0; n < 2; ++n) { const f32x4 r = *(const f32x4*)(R + off + bj * HALF + n * 16); *(f32x4*)(C + off + bj * HALF + n * 16) = r * alpha + acc[ai][bj][m][n]; }
                asm volatile("" ::: "memory"); }
    }
};
struct EpiSwiGLU {
    static constexpr bool PERM = true;
    bf16_t* Hb; PG8_LAS const int* rowbase;
    __device__ __forceinline__ void operator()(const f32x4 (&acc)[2][2][4][2], const Unit& u, int wr, int wc, int fr, int fq, PG8_LAS const int* tab) const {
        const int rb = __builtin_amdgcn_readfirstlane(rowbase[u.e]);
        const size_t row0 = (size_t)rb + u.pm * BM + wr * 64 + fr; const int col0 = u.pn * HALF + wc * 32 + 8 * fq;
#pragma unroll
        for (int ai = 0; ai < 2; ++ai)
#pragma unroll
            for (int m = 0; m < 4; ++m) { bf16_t* rowp = Hb + (row0 + ai * HALF + m * 16) * 512 + col0;
                float hv[8];
#pragma unroll
                for (int n = 0; n < 2; ++n)
#pragma unroll
                    for (int j = 0; j < 4; ++j) { const float g = acc[ai][0][m][n][j], uu = acc[ai][1][m][n][j];
                        hv[n * 4 + j] = g * __builtin_amdgcn_rcpf(1.0f + __builtin_amdgcn_exp2f(-1.44269504f * g)) * uu; }
                u32x4 w; w.x = cvt_pk_bf16(hv[0], hv[1]); w.y = cvt_pk_bf16(hv[2], hv[3]); w.z = cvt_pk_bf16(hv[4], hv[5]); w.w = cvt_pk_bf16(hv[6], hv[7]);
                *(u32x4*)rowp = w; }
    }
};
struct EpiDown {
    static constexpr bool PERM = true;
    bf16_t* Y; float* X2; float alpha; int nsh;
    __device__ __forceinline__ void operator()(const f32x4 (&acc)[2][2][4][2], const Unit& u, int wr, int wc, int fr, int fq, PG8_LAS const int* tab) const {
        const int col0 = u.pn * BM + wc * 32 + 8 * fq;
        if (u.e == nsh) {
            const int row0 = u.pm * BM + wr * 64 + fr;
#pragma unroll
            for (int ai = 0; ai < 2; ++ai)
#pragma unroll
                for (int m = 0; m < 4; ++m) { float* rowp = X2 + (size_t)(row0 + ai * HALF + m * 16) * 2048 + col0;
#pragma unroll
                    for (int bj = 0; bj < 2; ++bj)
#pragma unroll
                        for (int n = 0; n < 2; ++n) { const f32x4 r = *(const f32x4*)(rowp + bj * HALF + 4 * n); *(f32x4*)(rowp + bj * HALF + 4 * n) = r * alpha + acc[ai][bj][m][n]; }
                    asm volatile("" ::: "memory"); }
        } else {
#pragma unroll
            for (int ai = 0; ai < 2; ++ai)
#pragma unroll
                for (int m = 0; m < 4; ++m) { const int dst = tab[u.slot * 256 + ai * HALF + wr * 64 + m * 16 + fr];
                    if (dst >= 0) { bf16_t* rowp = Y + (size_t)dst * 2048 + col0;
#pragma unroll
                        for (int bj = 0; bj < 2; ++bj) { const f32x4 v0 = acc[ai][bj][m][0], v1 = acc[ai][bj][m][1];
                            u32x4 w; w.x = cvt_pk_bf16(v0[0], v0[1]); w.y = cvt_pk_bf16(v0[2], v0[3]); w.z = cvt_pk_bf16(v1[0], v1[1]); w.w = cvt_pk_bf16(v1[2], v1[3]);
                            *(u32x4*)(rowp + bj * HALF) = w; } } }
        }
    }
};

template <class Epi, class Sched, bool GATHER>
__device__ __forceinline__ void gemm_phase(PG8_LAS unsigned char* lds, const int K, const Sched& S, const Epi& E, PG8_LAS const int* tab) {
    const int tid = threadIdx.x, wid = __builtin_amdgcn_readfirstlane(tid >> 6), lane = tid & 63, wr = wid >> 2, wc = wid & 3, fr = lane & 15, fq = lane >> 4;
    const int nt = K / BK;
    int stR[2], stC[2]; unsigned voffB[2];
#pragma unroll
    for (int i = 0; i < 2; ++i) { int R, C; stage_rc(tid * 16 + i * 8192, R, C); const int Rb = Epi::PERM ? ((R & ~31) + perm32(R & 31)) : R; stR[i] = R; stC[i] = C; voffB[i] = (unsigned)(Rb * K + C) * 2u; }
    const size_t kstep = (size_t)(BK * 2);
    const size_t hstep = (size_t)HALF * K * 2;
    const unsigned ldsw = (unsigned)wid * 1024u;
    const int aoff = lds_byte(wr * 64 + fr, fq * 8), boff = lds_byte(wc * 32 + fr, fq * 8);
#define PG8_SA(b, h) (((b) * 2 + (h)) * HTB)
#define PG8_SB(b, h) ((4 + (b) * 2 + (h)) * HTB)
#define PG8_STAGE(bufoff, gbase, voff) do { _Pragma("unroll") for (int _i = 0; _i < 2; ++_i) \
        __builtin_amdgcn_global_load_lds((const unsigned*)((const char*)(gbase) + (voff)[_i]), (PG8_LAS unsigned*)(lds + (bufoff) + ldsw + _i * 8192), 16, 0, 0); } while (0)
#define PG8_LDA(dst, b, h) do { _Pragma("unroll") for (int m = 0; m < 4; ++m) _Pragma("unroll") for (int k = 0; k < 2; ++k) dst[m][k] = *(const PG8_LAS bf16x8*)(lds + PG8_SA(b, h) + aoff + m * 2048 + k * 1024); } while (0)
#define PG8_LDB(dst, b, h) do { _Pragma("unroll") for (int n = 0; n < 2; ++n) _Pragma("unroll") for (int k = 0; k < 2; ++k) dst[n][k] = *(const PG8_LAS bf16x8*)(lds + PG8_SB(b, h) + boff + n * 2048 + k * 1024); } while (0)
#define PG8_MMA(ai, bj, At, Bt) do { __builtin_amdgcn_s_setprio(1); _Pragma("unroll") for (int m = 0; m < 4; ++m) _Pragma("unroll") for (int n = 0; n < 2; ++n) _Pragma("unroll") for (int k = 0; k < 2; ++k) \
        acc[ai][bj][m][n] = __builtin_amdgcn_mfma_f32_16x16x32_bf16(Bt[n][k], At[m][k], acc[ai][bj][m][n], 0, 0, 0); __builtin_amdgcn_s_setprio(0); } while (0)
#define PG8_WAIT_V(n) asm volatile("s_waitcnt vmcnt(" #n ")" ::: "memory")
#define PG8_WAIT_L(n) asm volatile("s_waitcnt lgkmcnt(" #n ")" ::: "memory")
#define PG8_BAR __builtin_amdgcn_s_barrier()
#define PG8_SCHED __builtin_amdgcn_sched_barrier(0)
#define PG8_VOFF(u, v) do { _Pragma("unroll") for (int _h = 0; _h < 2; ++_h) _Pragma("unroll") for (int _i = 0; _i < 2; ++_i) { \
        if (GATHER) { const int _row = tab[(u).slot * 256 + _h * HALF + stR[_i]]; v[_h][_i] = (unsigned)_row * (unsigned)(K * 2) + (unsigned)(stC[_i] * 2); } \
        else v[_h][_i] = (unsigned)(stR[_i] * K + stC[_i]) * 2u + (unsigned)(_h * hstep); } } while (0)
    Unit cur, nxt; int ui = 0;
    if (!S.next(0, cur)) return;
    f32x4 acc[2][2][4][2];
#pragma unroll
    for (int a = 0; a < 2; ++a)
#pragma unroll
        for (int b = 0; b < 2; ++b)
#pragma unroll
            for (int m = 0; m < 4; ++m)
#pragma unroll
                for (int n = 0; n < 2; ++n) acc[a][b][m][n] = (f32x4){0.f, 0.f, 0.f, 0.f};
    bf16x8 At[4][2], B0[2][2], B1[2][2];
    unsigned vA[2][2], vAn[2][2];
    PG8_VOFF(cur, vA);
    if (GATHER) PG8_WAIT_L(0);
    const char* cA = cur.A; const char* cB = cur.B;
    PG8_STAGE(PG8_SB(0, 0), cB, voffB); PG8_STAGE(PG8_SB(0, 1), cB + hstep, voffB); PG8_STAGE(PG8_SA(0, 0), cA, vA[0]); PG8_STAGE(PG8_SA(0, 1), cA, vA[1]);
    if (wr == 1) PG8_BAR;
    PG8_WAIT_V(2); PG8_BAR;
    PG8_STAGE(PG8_SB(1, 0), cB + kstep, voffB); PG8_STAGE(PG8_SA(1, 0), cA + kstep, vA[0]); PG8_STAGE(PG8_SB(1, 1), cB + hstep + kstep, voffB);
    PG8_WAIT_V(6); PG8_BAR;
    for (;;) {
        const bool has_next = S.next(ui + 1, nxt);
        const char* nA = has_next ? nxt.A : cA; const char* nB = has_next ? nxt.B : cB;
        if (has_next) { PG8_VOFF(nxt, vAn); } else {
#pragma unroll
            for (int h = 0; h < 2; ++h)
#pragma unroll
                for (int i = 0; i < 2; ++i) vAn[h][i] = vA[h][i]; }
        for (int t = 0; t < nt; t += 2) {
            const bool last = (t == nt - 2);
            const char* a1 = cA + (size_t)(t + 1) * kstep;
            const char* a2 = last ? nA : cA + (size_t)(t + 2) * kstep; const char* b2 = last ? nB : cB + (size_t)(t + 2) * kstep;
            const char* a3 = a2 + kstep; const char* b3 = b2 + kstep;
            unsigned w0[2], w1[2];
#pragma unroll
            for (int i = 0; i < 2; ++i) { w0[i] = last ? vAn[0][i] : vA[0][i]; w1[i] = last ? vAn[1][i] : vA[1][i]; }
            PG8_LDB(B0, 0, 0); PG8_LDB(B1, 0, 1); PG8_SCHED; PG8_LDA(At, 0, 0); PG8_STAGE(PG8_SA(1, 1), a1, vA[1]);
            PG8_WAIT_V(8); PG8_WAIT_L(0); PG8_BAR; PG8_MMA(0, 0, At, B0); PG8_MMA(0, 1, At, B1); PG8_BAR; PG8_SCHED;
            PG8_LDA(At, 0, 1); PG8_STAGE(PG8_SB(0, 0), b2, voffB); PG8_STAGE(PG8_SB(0, 1), b2 + hstep, voffB); PG8_STAGE(PG8_SA(0, 0), a2, w0);
            PG8_WAIT_V(8); PG8_WAIT_L(0); PG8_BAR; PG8_MMA(1, 0, At, B0); PG8_MMA(1, 1, At, B1); PG8_BAR; PG8_SCHED;
            PG8_LDB(B0, 1, 0); PG8_LDB(B1, 1, 1); PG8_SCHED; PG8_LDA(At, 1, 0); PG8_STAGE(PG8_SA(0, 1), a2, w1);
            PG8_WAIT_V(8); PG8_WAIT_L(0); PG8_BAR; PG8_MMA(0, 0, At, B0); PG8_MMA(0, 1, At, B1); PG8_BAR; PG8_SCHED;
            PG8_LDA(At, 1, 1); PG8_STAGE(PG8_SB(1, 0), b3, voffB); PG8_STAGE(PG8_SB(1, 1), b3 + hstep, voffB); PG8_STAGE(PG8_SA(1, 0), a3, w0);
            PG8_WAIT_V(8); PG8_WAIT_L(0); PG8_BAR; PG8_MMA(1, 0, At, B0); PG8_MMA(1, 1, At, B1); PG8_BAR; PG8_SCHED;
        }
        if (wr == 0) PG8_BAR;
        E(acc, cur, wr, wc, fr, fq, tab);
        if (!has_next) break;
#pragma unroll
        for (int a = 0; a < 2; ++a)
#pragma unroll
            for (int b = 0; b < 2; ++b)
#pragma unroll
                for (int m = 0; m < 4; ++m)
#pragma unroll
                    for (int n = 0; n < 2; ++n) acc[a][b][m][n] = (f32x4){0.f, 0.f, 0.f, 0.f};
        cur = nxt; cA = nA; cB = nB; ++ui;
#pragma unroll
        for (int h = 0; h < 2; ++h)
#pragma unroll
            for (int i = 0; i < 2; ++i) vA[h][i] = vAn[h][i];
        if (wr == 1) PG8_BAR;
    }
    PG8_WAIT_V(0);
    PG8_BAR;
#undef PG8_SA
#undef PG8_SB
#undef PG8_STAGE
#undef PG8_LDA
#undef PG8_LDB
#undef PG8_MMA
#undef PG8_WAIT_V
#undef PG8_WAIT_L
#undef PG8_BAR
#undef PG8_SCHED
#undef PG8_VOFF
}
}
namespace mk {
#define GAS __attribute__((address_space(1)))
#define LAS __attribute__((address_space(3)))
typedef unsigned short bf16;
typedef unsigned u32x4 __attribute__((ext_vector_type(4)));
typedef unsigned u32x2 __attribute__((ext_vector_type(2)));
typedef float f32x4 __attribute__((ext_vector_type(4)));
typedef short bf16x8 __attribute__((ext_vector_type(8)));
typedef short s16x4 __attribute__((ext_vector_type(4)));
typedef GAS unsigned gu32;
#define RLX_AGENT __ATOMIC_RELAXED, __HIP_MEMORY_SCOPE_AGENT
#define LDS_WAIT() asm volatile("s_waitcnt lgkmcnt(0)" ::: "memory")
#define VM_WAIT() asm volatile("s_waitcnt vmcnt(0)" ::: "memory")

constexpr int NWAVES = 8;
constexpr int NTOK = 16384, DM = 2048, SEQL = 4096, NB = 4, AW = 1024, HD = 128, NH = 8, INC = 6144;
constexpr int MEML = 256, NMH = 4, MHD = 512, NE = 64, NEX = 65  , TOPK = 8, FF = 512, CAP = 16384;
constexpr float LN_EPS = 1e-5f, RMS_EPS = 1e-6f, ALPHA = 1.189207115002721f;
constexpr float QSCALE = 0.08838834764831845f * 1.4426950408889634f;
constexpr float MQSCALE = 0.04419417382415922f * 1.4426950408889634f;
constexpr int HROWS = 131072 + 64 * 256 + 16384;

constexpr size_t MiB = 1u << 20;
constexpr size_t WS_CTL = 0, CTL_ZERO_BYTES = 1 * MiB;
constexpr size_t WS_WD = 2 * MiB;
constexpr size_t WS_WGU = 132 * MiB;
constexpr size_t WS_Y = 132 * MiB;
constexpr size_t WS_WIN = 392 * MiB, WS_WOUT = 416 * MiB, WS_WQ = 424 * MiB, WS_WKV = 432 * MiB, WS_WO = 448 * MiB, WS_WR = 456 * MiB;
constexpr size_t WS_OG = 457 * MiB;
constexpr size_t WS_QM = 457 * MiB, WS_OM = 521 * MiB;
constexpr size_t WS_MIXED = 553 * MiB;
constexpr size_t WS_XB = 644 * MiB, WS_MB = 708 * MiB;
constexpr size_t WS_T = 644 * MiB;
constexpr size_t WS_H = 644 * MiB;
constexpr size_t WS_PROJ = 804 * MiB;
constexpr size_t WS_X1 = 804 * MiB;
constexpr size_t WS_X1B = 932 * MiB;
constexpr size_t WS_KVM = 996 * MiB;
constexpr size_t WS_LSE = 1004 * MiB;
constexpr size_t WS_GATES = 1006 * MiB;
constexpr size_t WS_LTOK = 1007 * MiB, WS_LSLOT = 1011 * MiB;
constexpr size_t WS_END = 1016 * MiB;
constexpr int CW_TMO = 0, CW_CODE = 1, CW_BAR = 4096, CW_CNT = 16384;

constexpr int RING_OFF = 0, RING_BYTES = 131072, TAB_OFF = 131072, TAB_BYTES = 24576, MISC_OFF = TAB_OFF + TAB_BYTES, MISC_BYTES = 2048;
constexpr int LDS_BYTES = MISC_OFF + MISC_BYTES;
constexpr int MAXU = 24;
constexpr int MW_PRE = 16, MW_RB = 96, MW_CNT = 176, MW_UL = 256, MW_NM = 300;

__device__ __forceinline__ unsigned f2bf(float f) { unsigned u = __builtin_bit_cast(unsigned, f); return (u + 0x7fffu + ((u >> 16) & 1u)) >> 16; }
__device__ __forceinline__ unsigned pk2(float lo, float hi) { return pg8::cvt_pk_bf16(lo, hi); }
__device__ __forceinline__ float bf2f(unsigned short b) { return __builtin_bit_cast(float, (unsigned)b << 16); }
__device__ __forceinline__ float bflo(unsigned w) { return __builtin_bit_cast(float, w << 16); }
__device__ __forceinline__ float bfhi(unsigned w) { return __builtin_bit_cast(float, w & 0xffff0000u); }

#define XB_TMO      128
#define XB_XCNT(j)  (256  + 64 * (j))
#define XB_XSUB(j)  (1280 + 64 * (j))
#define XB_XGEN(j)  (2304 + 64 * (j))
#define XB_TOP      3328
#define XB_TOPGEN   3392
#define XCD_BAR_WORDS 3456
#define XB_SPIN_CAP (1u << 18)
__device__ __forceinline__ unsigned xb_ld(unsigned* p)              { return __hip_atomic_load(p, __ATOMIC_RELAXED, __HIP_MEMORY_SCOPE_AGENT); }
__device__ __forceinline__ unsigned xb_add(unsigned* p, unsigned v) { return __hip_atomic_fetch_add(p, v, __ATOMIC_RELAXED, __HIP_MEMORY_SCOPE_AGENT); }
__device__ __forceinline__ unsigned xb_xcc_id() { return (unsigned)__builtin_amdgcn_s_getreg((3 << 11) | 20) & 0xFu; }
#define XB_SPIN(cond, bar) do { unsigned _sp = 0; while (cond) { __builtin_amdgcn_s_sleep(1); \
    if ((++_sp & 255u) == 0u) { if (xb_ld(&(bar)[XB_TMO])) break; if (_sp > XB_SPIN_CAP) { atomicAdd(&(bar)[XB_TMO], 1u); break; } } } } while (0)
struct XcdBarrier { unsigned* bar; unsigned x; volatile LAS unsigned* st; };
__device__ __forceinline__ XcdBarrier xcd_barrier_post(unsigned* bar, volatile LAS unsigned* st) {
    XcdBarrier b; b.bar = bar; b.x = xb_xcc_id(); b.st = st;
    if (threadIdx.x == 0) (void)xb_add(&bar[XB_XCNT(b.x)], 1u);
    return b;
}
__device__ __forceinline__ void xcd_barrier_complete(unsigned* bar, unsigned x, unsigned& nloc, unsigned& nx) {
    const unsigned G = gridDim.x * gridDim.y * gridDim.z;
    unsigned sum, cnt, mine, sp = 0u;
    for (;;) {
        sum = 0u; cnt = 0u; mine = 0u;
#pragma unroll
        for (unsigned j = 0; j < 16; ++j) { const unsigned c = xb_ld(&bar[XB_XCNT(j)]); sum += c; cnt += (c > 0u) ? 1u : 0u; mine = (j == x) ? c : mine; }
        if (sum == G) break;
        __builtin_amdgcn_s_sleep(1);
        if ((++sp & 255u) == 0u) { if (xb_ld(&bar[XB_TMO])) break; if (sp > XB_SPIN_CAP) { atomicAdd(&bar[XB_TMO], 1u); break; } }
    }
    nloc = mine > 0u ? mine : 1u; nx = cnt > 0u ? cnt : 1u;
}
__device__ __forceinline__ void xcd_barrier(const XcdBarrier& b) {
    asm volatile("s_waitcnt vmcnt(0)" ::: "memory");
    __syncthreads();
    if (threadIdx.x == 0) {
        unsigned* bar = b.bar;
        __builtin_amdgcn_s_waitcnt(0);
        unsigned nloc = b.st[0], nx = b.st[1];
        if (nloc == 0u) { xcd_barrier_complete(bar, b.x, nloc, nx); b.st[0] = nloc; b.st[1] = nx; }
        const unsigned old = xb_add(&bar[XB_XSUB(b.x)], 1u);
        const unsigned gen = old / nloc;
        if (old + 1u == (gen + 1u) * nloc) {
            __builtin_amdgcn_fence(__ATOMIC_RELEASE, "agent");
            asm volatile("s_waitcnt vmcnt(0)" ::: "memory");
            const unsigned og = xb_add(&bar[XB_TOP], 1u);
            const unsigned tg = og / nx;
            if (og + 1u == (tg + 1u) * nx) xb_add(&bar[XB_TOPGEN], 1u);
            else XB_SPIN(xb_ld(&bar[XB_TOPGEN]) == tg, bar);
            __builtin_amdgcn_fence(__ATOMIC_ACQUIRE, "agent");
            xb_add(&bar[XB_XGEN(b.x)], 1u);
            asm volatile("s_waitcnt vmcnt(0)" ::: "memory");
        } else {
            XB_SPIN(xb_ld(&bar[XB_XGEN(b.x)]) == gen, bar);
            __builtin_amdgcn_fence(__ATOMIC_ACQUIRE, "agent");
            asm volatile("s_waitcnt vmcnt(0)" ::: "memory");
        }
    }
    __syncthreads();
}

struct Args { const float* in[24]; float* out; unsigned char* ws; int ph_lo, ph_hi, use_bar, pad; };
struct Frame {
    LAS unsigned char* lds; volatile LAS unsigned* MISC; gu32* ctl; unsigned char* ws;
    int tid, lane, wave, vcu, G;
};
__device__ __forceinline__ float wave_sum(float v) {
#pragma unroll
    for (int o = 1; o < 64; o <<= 1) v += __shfl_xor(v, o);
    return v;
}

__device__ __forceinline__ void p0_tr_item(const float* W, int ldw, int K, bf16* WT, int k0, int n0, int drow0, LAS float* scr, int lane) {
#pragma unroll 4
    for (int p = 0; p < 16; ++p) { const int kk = p * 4 + (lane >> 4); const f32x4 v = *(const GAS f32x4*)(W + (size_t)(k0 + kk) * ldw + n0 + 4 * (lane & 15));
        LAS float* d = scr + kk * 65 + 4 * (lane & 15); d[0] = v.x; d[1] = v.y; d[2] = v.z; d[3] = v.w; }
    LDS_WAIT(); asm volatile("" ::: "memory");
    const int c = lane & 7;
#pragma unroll
    for (int j = 0; j < 8; ++j) { const int n = (lane >> 3) + 8 * j; const LAS float* s = scr + (8 * c) * 65 + n;
        u32x4 o; o.x = pk2(s[0 * 65], s[1 * 65]); o.y = pk2(s[2 * 65], s[3 * 65]); o.z = pk2(s[4 * 65], s[5 * 65]); o.w = pk2(s[6 * 65], s[7 * 65]);
        *(GAS u32x4*)(WT + (size_t)(drow0 + n) * K + k0 + 8 * c) = o; }
    LDS_WAIT(); asm volatile("" ::: "memory");
}
__device__ __forceinline__ void p0_prologue(Frame& F, const Args& a) {
    LAS float* scr = (LAS float*)(F.lds + F.wave * 16640);
    const int gw = F.vcu * NWAVES + F.wave, NGW = F.G * NWAVES;
    const float* x = a.in[0]; const float* mem = a.in[1]; const float* w_in = a.in[2]; const float* w_out = a.in[6]; const float* wq = a.in[9]; const float* wkv = a.in[10]; const float* wo = a.in[11];
    const float* wr = a.in[14]; const float* wg = a.in[16]; const float* wu = a.in[17]; const float* wd = a.in[18]; const float* wsg = a.in[19]; const float* wsu = a.in[20]; const float* wsd = a.in[21];
    bf16* Win_t = (bf16*)(F.ws + WS_WIN); bf16* Wout_t = (bf16*)(F.ws + WS_WOUT); bf16* Wq_t = (bf16*)(F.ws + WS_WQ); bf16* Wkv_t = (bf16*)(F.ws + WS_WKV); bf16* Wo_t = (bf16*)(F.ws + WS_WO);
    bf16* Wgu_t = (bf16*)(F.ws + WS_WGU); bf16* Wd_t = (bf16*)(F.ws + WS_WD);
    constexpr int I_GU = 32 * 8, I_D = 8 * 32;
    constexpr int I_EXP = NEX * (2 * I_GU + I_D);
    constexpr int I_IN = 32 * 96, I_SQ = 32 * 32, I_KV = 32 * 64;
    constexpr int NITEMS = I_EXP + I_IN + 3 * I_SQ + I_KV;
    for (int it = gw; it < NITEMS; it += NGW) {
        int r = it;
        if (r < I_EXP) {
            const int e = r / (2 * I_GU + I_D); int q = r % (2 * I_GU + I_D);
            if (q < 2 * I_GU) { const int up = q >= I_GU; if (up) q -= I_GU; const int kb = q / 8, nb = q % 8;
                const float* W = (e < NE) ? (up ? wu : wg) + (size_t)e * DM * FF : (up ? wsu : wsg);
                const int n0 = nb * 64, drow0 = (n0 >> 7) * 256 + (up ? 128 : 0) + (n0 & 127);
                p0_tr_item(W, FF, DM, Wgu_t + (size_t)e * 1024 * DM, kb * 64, n0, drow0, scr, F.lane);
            } else { q -= 2 * I_GU; const int kb = q / 32, nb = q % 32;
                const float* W = (e < NE) ? wd + (size_t)e * FF * DM : wsd;
                p0_tr_item(W, DM, FF, Wd_t + (size_t)e * DM * FF, kb * 64, nb * 64, nb * 64, scr, F.lane); }
            continue; }
        r -= I_EXP;
        if (r < I_IN) { p0_tr_item(w_in, INC, DM, Win_t, (r / 96) * 64, (r % 96) * 64, (r % 96) * 64, scr, F.lane); continue; } r -= I_IN;
        if (r < I_SQ) { p0_tr_item(w_out, DM, DM, Wout_t, (r / 32) * 64, (r % 32) * 64, (r % 32) * 64, scr, F.lane); continue; } r -= I_SQ;
        if (r < I_SQ) { p0_tr_item(wq, DM, DM, Wq_t, (r / 32) * 64, (r % 32) * 64, (r % 32) * 64, scr, F.lane); continue; } r -= I_SQ;
        if (r < I_SQ) { p0_tr_item(wo, DM, DM, Wo_t, (r / 32) * 64, (r % 32) * 64, (r % 32) * 64, scr, F.lane); continue; } r -= I_SQ;
        p0_tr_item(wkv, 2 * DM, DM, Wkv_t, (r / 64) * 64, (r % 64) * 64, (r % 64) * 64, scr, F.lane);
    }
    { const size_t gt = (size_t)(F.vcu * NWAVES * 64) + F.tid, NT = (size_t)F.G * NWAVES * 64;
      bf16* Xb = (bf16*)(F.ws + WS_XB); bf16* Mb = (bf16*)(F.ws + WS_MB);
      for (size_t i = gt; i < (size_t)NTOK * DM / 8; i += NT) { const f32x4 v0 = *(const GAS f32x4*)(x + i * 8), v1 = *(const GAS f32x4*)(x + i * 8 + 4);
          u32x4 o; o.x = pk2(v0.x, v0.y); o.y = pk2(v0.z, v0.w); o.z = pk2(v1.x, v1.y); o.w = pk2(v1.z, v1.w); *(GAS u32x4*)(Xb + i * 8) = o; }
      for (size_t i = gt; i < (size_t)NB * MEML * DM / 8; i += NT) { const f32x4 v0 = *(const GAS f32x4*)(mem + i * 8), v1 = *(const GAS f32x4*)(mem + i * 8 + 4);
          u32x4 o; o.x = pk2(v0.x, v0.y); o.y = pk2(v0.z, v0.w); o.z = pk2(v1.x, v1.y); o.w = pk2(v1.z, v1.w); *(GAS u32x4*)(Mb + i * 8) = o; }
      bf16* Wr = (bf16*)(F.ws + WS_WR);
      for (size_t i = gt; i < (size_t)NE * DM; i += NT) { const int e = (int)(i / DM), k = (int)(i % DM); const float w = wr[(size_t)k * NE + e]; const unsigned h = f2bf(w); const float lo = w - __builtin_bit_cast(float, h << 16);
          Wr[i] = (bf16)h; Wr[(size_t)NE * DM + i] = (bf16)f2bf(lo); } }
}

constexpr int DA_STRIDE = 288, DA_KOFF = 0, DA_VOFF = 256 * DA_STRIDE;
__device__ __forceinline__ void dattn_unit(Frame& F, int uid) {
    const bf16* Qp = (const bf16*)(F.ws + WS_PROJ); const bf16* Kp = Qp + (size_t)NTOK * AW; const bf16* Vp = Kp + (size_t)NTOK * AW;
    bf16* og = (bf16*)(F.ws + WS_OG); float* lse = (float*)(F.ws + WS_LSE);
    const int bh = uid / 96, k96 = uid % 96, g = k96 >> 5, rem = k96 & 31, d = 1 << (2 * g), tps = 32 >> (2 * g);
    const int r = rem / tps, n = rem % tps, b = bh >> 3, h = bh & 7;
    const int tid = F.tid, lane = F.lane, w = F.wave, fr = lane & 15, fq = lane >> 4;
    LAS unsigned char* lds = F.lds;
    {
        u32x4 kr[8], vr[8];
#pragma unroll
        for (int p = 0; p < 8; ++p) { const int kb = p * 32 + (tid >> 4), ch = tid & 15, ki = 128 * n - 128 + kb;
            if (ki >= 0) { const size_t off = ((size_t)(b * SEQL + ki * d + r)) * AW + h * HD + ch * 8; kr[p] = *(const GAS u32x4*)(Kp + off); vr[p] = *(const GAS u32x4*)(Vp + off); }
            else { kr[p] = (u32x4){0u, 0u, 0u, 0u}; vr[p] = kr[p]; } }
#pragma unroll
        for (int p = 0; p < 8; ++p) { const int kb = p * 32 + (tid >> 4), ch = tid & 15;
            *(LAS u32x4*)(lds + DA_KOFF + kb * DA_STRIDE + ch * 16) = kr[p]; *(LAS u32x4*)(lds + DA_VOFF + kb * DA_STRIDE + ch * 16) = vr[p]; }
    }
    const int qi = 128 * n + 16 * w + fr; const size_t tq = (size_t)(b * SEQL + qi * d + r);
    bf16x8 qf[4];
#pragma unroll
    for (int ks = 0; ks < 4; ++ks) qf[ks] = *(const GAS bf16x8*)(Qp + tq * AW + h * HD + 32 * ks + 8 * fq);
    __syncthreads();
    const int kstart = 32 * (w >> 1);
    f32x4 S[10];
#pragma unroll
    for (int T = 0; T < 10; ++T) { S[T] = (f32x4){0.f, 0.f, 0.f, 0.f};
#pragma unroll
        for (int ks = 0; ks < 4; ++ks) { const bf16x8 kf = *(const LAS bf16x8*)(lds + DA_KOFF + (kstart + 16 * T + fr) * DA_STRIDE + (32 * ks + 8 * fq) * 2);
            S[T] = __builtin_amdgcn_mfma_f32_16x16x32_bf16(kf, qf[ks], S[T], 0, 0, 0); } }
    const int qb = 128 + 16 * w + fr; float mx = -INFINITY;
#pragma unroll
    for (int T = 0; T < 10; ++T)
#pragma unroll
        for (int j = 0; j < 4; ++j) { const int kb = kstart + 16 * T + 4 * fq + j, dist = qb - kb; const bool ok = dist >= 0 && dist <= 128 && (n > 0 || kb >= 128);
            S[T][j] = ok ? S[T][j] : -INFINITY; mx = fmaxf(mx, S[T][j]); }
    mx = fmaxf(mx, __shfl_xor(mx, 16)); mx = fmaxf(mx, __shfl_xor(mx, 32));
    float sum = 0.f;
#pragma unroll
    for (int T = 0; T < 10; ++T)
#pragma unroll
        for (int j = 0; j < 4; ++j) { const float p = __builtin_amdgcn_exp2f(S[T][j] - mx); S[T][j] = p; sum += p; }
    sum += __shfl_xor(sum, 16); sum += __shfl_xor(sum, 32);
    bf16x8 pf[5];
#pragma unroll
    for (int s = 0; s < 5; ++s) { u32x4 wv; wv.x = pk2(S[2 * s][0], S[2 * s][1]); wv.y = pk2(S[2 * s][2], S[2 * s][3]); wv.z = pk2(S[2 * s + 1][0], S[2 * s + 1][1]); wv.w = pk2(S[2 * s + 1][2], S[2 * s + 1][3]); pf[s] = __builtin_bit_cast(bf16x8, wv); }
    f32x4 O[8];
#pragma unroll
    for (int dt = 0; dt < 8; ++dt) O[dt] = (f32x4){0.f, 0.f, 0.f, 0.f};
    const int q4 = fr >> 2, p4 = fr & 3;
    LAS unsigned char* vbase = lds + DA_VOFF + (kstart + 4 * fq + q4) * DA_STRIDE + p4 * 8;
#pragma unroll
    for (int s = 0; s < 5; ++s)
#pragma unroll
        for (int dt = 0; dt < 8; ++dt) {
            const s16x4 lo = __builtin_amdgcn_ds_read_tr16_b64_v4i16((LAS s16x4*)(vbase + (32 * s) * DA_STRIDE + dt * 32));
            const s16x4 hi = __builtin_amdgcn_ds_read_tr16_b64_v4i16((LAS s16x4*)(vbase + (32 * s + 16) * DA_STRIDE + dt * 32));
            const bf16x8 vf = {lo[0], lo[1], lo[2], lo[3], hi[0], hi[1], hi[2], hi[3]};
            O[dt] = __builtin_amdgcn_mfma_f32_16x16x32_bf16(vf, pf[s], O[dt], 0, 0, 0); }
    const float inv = 1.0f / sum;
    bf16* orow = og + ((size_t)g * NTOK + tq) * AW + h * HD + 4 * fq;
#pragma unroll
    for (int dt = 0; dt < 8; ++dt) { u32x2 o; o.x = pk2(O[dt][0] * inv, O[dt][1] * inv); o.y = pk2(O[dt][2] * inv, O[dt][3] * inv); *(GAS u32x2*)(orow + 16 * dt) = o; }
    if (fq == 0) lse[((size_t)g * NTOK + tq) * NH + h] = mx + __builtin_amdgcn_logf(sum);
    __syncthreads();
}

__device__ __forceinline__ void p3_token(Frame& F, const Args& a, int t) {
    const bf16* proj = (const bf16*)(F.ws + WS_PROJ); const bf16* og = (const bf16*)(F.ws + WS_OG); const float* lse = (const float*)(F.ws + WS_LSE);
    bf16* mixed = (bf16*)(F.ws + WS_MIXED);
    const float* conv_w = a.in[3]; const float* g_attn = a.in[4]; const float* g_conv = a.in[5];
    const int lane = F.lane, c0 = lane * 16, h = lane >> 3, s = t % SEQL;
    float l0 = lse[(size_t)t * NH + h], l1 = lse[((size_t)NTOK + t) * NH + h], l2 = lse[((size_t)2 * NTOK + t) * NH + h];
    const float lm = fmaxf(l0, fmaxf(l1, l2)); float w0 = __builtin_amdgcn_exp2f(l0 - lm), w1 = __builtin_amdgcn_exp2f(l1 - lm), w2 = __builtin_amdgcn_exp2f(l2 - lm);
    const float wi = 1.0f / (w0 + w1 + w2); w0 *= wi; w1 *= wi; w2 *= wi;
    float av[16], cv[16];
    {
        const u32x4 a0 = *(const GAS u32x4*)(og + (size_t)t * AW + c0), a1 = *(const GAS u32x4*)(og + (size_t)t * AW + c0 + 8);
        const u32x4 b0 = *(const GAS u32x4*)(og + ((size_t)NTOK + t) * AW + c0), b1 = *(const GAS u32x4*)(og + ((size_t)NTOK + t) * AW + c0 + 8);
        const u32x4 d0 = *(const GAS u32x4*)(og + ((size_t)2 * NTOK + t) * AW + c0), d1 = *(const GAS u32x4*)(og + ((size_t)2 * NTOK + t) * AW + c0 + 8);
#pragma unroll
        for (int i = 0; i < 4; ++i) { av[2 * i] = w0 * bflo(a0[i]) + w1 * bflo(b0[i]) + w2 * bflo(d0[i]); av[2 * i + 1] = w0 * bfhi(a0[i]) + w1 * bfhi(b0[i]) + w2 * bfhi(d0[i]);
            av[8 + 2 * i] = w0 * bflo(a1[i]) + w1 * bflo(b1[i]) + w2 * bflo(d1[i]); av[8 + 2 * i + 1] = w0 * bfhi(a1[i]) + w1 * bfhi(b1[i]) + w2 * bfhi(d1[i]); }
    }
    {
        const bf16* Bg = proj + (size_t)3 * NTOK * AW; const bf16* Cg = proj + (size_t)4 * NTOK * AW; const bf16* Hg = proj + (size_t)5 * NTOK * AW;
#pragma unroll
        for (int i = 0; i < 16; ++i) cv[i] = 0.f;
#pragma unroll
        for (int tap = 0; tap < 3; ++tap) { const int back = 2 - tap;
            if (s - back >= 0) { const size_t off = (size_t)(t - back) * AW + c0;
                const u32x4 cA = *(const GAS u32x4*)(Cg + off), cB = *(const GAS u32x4*)(Cg + off + 8), hA = *(const GAS u32x4*)(Hg + off), hB = *(const GAS u32x4*)(Hg + off + 8);
                const f32x4 wv0 = *(const GAS f32x4*)(conv_w + tap * AW + c0), wv1 = *(const GAS f32x4*)(conv_w + tap * AW + c0 + 4), wv2 = *(const GAS f32x4*)(conv_w + tap * AW + c0 + 8), wv3 = *(const GAS f32x4*)(conv_w + tap * AW + c0 + 12);
                const float wv[16] = {wv0.x, wv0.y, wv0.z, wv0.w, wv1.x, wv1.y, wv1.z, wv1.w, wv2.x, wv2.y, wv2.z, wv2.w, wv3.x, wv3.y, wv3.z, wv3.w};
#pragma unroll
                for (int i = 0; i < 4; ++i) { cv[2 * i] += wv[2 * i] * bflo(cA[i]) * bflo(hA[i]); cv[2 * i + 1] += wv[2 * i + 1] * bfhi(cA[i]) * bfhi(hA[i]);
                    cv[8 + 2 * i] += wv[8 + 2 * i] * bflo(cB[i]) * bflo(hB[i]); cv[8 + 2 * i + 1] += wv[8 + 2 * i + 1] * bfhi(cB[i]) * bfhi(hB[i]); } } }
        const u32x4 bA = *(const GAS u32x4*)(Bg + (size_t)t * AW + c0), bB = *(const GAS u32x4*)(Bg + (size_t)t * AW + c0 + 8);
#pragma unroll
        for (int i = 0; i < 4; ++i) { cv[2 * i] *= bflo(bA[i]); cv[2 * i + 1] *= bfhi(bA[i]); cv[8 + 2 * i] *= bflo(bB[i]); cv[8 + 2 * i + 1] *= bfhi(bB[i]); }
    }
    float sa = 0.f, sc = 0.f;
#pragma unroll
    for (int i = 0; i < 16; ++i) { sa += av[i] * av[i]; sc += cv[i] * cv[i]; }
    sa = wave_sum(sa); sc = wave_sum(sc);
    const float ra = __builtin_amdgcn_rsqf(sa * (1.0f / 1024.f) + RMS_EPS), rc = __builtin_amdgcn_rsqf(sc * (1.0f / 1024.f) + RMS_EPS);
    u32x4 oa0, oa1, oc0, oc1;
    {
        const f32x4 g0 = *(const GAS f32x4*)(g_attn + c0), g1 = *(const GAS f32x4*)(g_attn + c0 + 4), g2 = *(const GAS f32x4*)(g_attn + c0 + 8), g3 = *(const GAS f32x4*)(g_attn + c0 + 12);
        oa0.x = pk2(av[0] * ra * g0.x, av[1] * ra * g0.y); oa0.y = pk2(av[2] * ra * g0.z, av[3] * ra * g0.w); oa0.z = pk2(av[4] * ra * g1.x, av[5] * ra * g1.y); oa0.w = pk2(av[6] * ra * g1.z, av[7] * ra * g1.w);
        oa1.x = pk2(av[8] * ra * g2.x, av[9] * ra * g2.y); oa1.y = pk2(av[10] * ra * g2.z, av[11] * ra * g2.w); oa1.z = pk2(av[12] * ra * g3.x, av[13] * ra * g3.y); oa1.w = pk2(av[14] * ra * g3.z, av[15] * ra * g3.w);
        const f32x4 k0 = *(const GAS f32x4*)(g_conv + c0), k1 = *(const GAS f32x4*)(g_conv + c0 + 4), k2 = *(const GAS f32x4*)(g_conv + c0 + 8), k3 = *(const GAS f32x4*)(g_conv + c0 + 12);
        oc0.x = pk2(cv[0] * rc * k0.x, cv[1] * rc * k0.y); oc0.y = pk2(cv[2] * rc * k0.z, cv[3] * rc * k0.w); oc0.z = pk2(cv[4] * rc * k1.x, cv[5] * rc * k1.y); oc0.w = pk2(cv[6] * rc * k1.z, cv[7] * rc * k1.w);
        oc1.x = pk2(cv[8] * rc * k2.x, cv[9] * rc * k2.y); oc1.y = pk2(cv[10] * rc * k2.z, cv[11] * rc * k2.w); oc1.z = pk2(cv[12] * rc * k3.x, cv[13] * rc * k3.y); oc1.w = pk2(cv[14] * rc * k3.z, cv[15] * rc * k3.w);
    }
    bf16* mrow = mixed + (size_t)t * DM + c0;
    *(GAS u32x4*)(mrow) = oa0; *(GAS u32x4*)(mrow + 8) = oa1; *(GAS u32x4*)(mrow + AW) = oc0; *(GAS u32x4*)(mrow + AW + 8) = oc1;
}

__device__ __forceinline__ void ln_row(const float* in, const float* g, const float* bta, float* outf, bf16* outb, int lane) {
    const GAS f32x4* xr = (const GAS f32x4*)in + lane;
    f32x4 v[8]; float s = 0.f;
#pragma unroll
    for (int j = 0; j < 8; ++j) { v[j] = xr[64 * j]; s += (v[j].x + v[j].y) + (v[j].z + v[j].w); }
    const float mean = wave_sum(s) * (1.f / DM); float s2 = 0.f;
#pragma unroll
    for (int j = 0; j < 8; ++j) { v[j] = v[j] - mean; s2 += (v[j].x * v[j].x + v[j].y * v[j].y) + (v[j].z * v[j].z + v[j].w * v[j].w); }
    const float rstd = __builtin_amdgcn_rsqf(wave_sum(s2) * (1.f / DM) + LN_EPS);
#pragma unroll
    for (int j = 0; j < 8; ++j) { const f32x4 gg = *((const GAS f32x4*)g + lane + 64 * j), bb = *((const GAS f32x4*)bta + lane + 64 * j);
        const f32x4 o = v[j] * rstd * gg + bb;
        *((GAS f32x4*)outf + lane + 64 * j) = o;
        if (outb) { u32x2 w; w.x = pk2(o.x, o.y); w.y = pk2(o.z, o.w); *((GAS u32x2*)outb + lane + 64 * j) = w; } }
}

constexpr int XA_STRIDE = 144, XA_BUF = 256 * XA_STRIDE;
__device__ __forceinline__ void xattn_unit(Frame& F, int uid) {
    const bf16* Qm = (const bf16*)(F.ws + WS_QM); const bf16* KVm = (const bf16*)(F.ws + WS_KVM); bf16* Om = (bf16*)(F.ws + WS_OM);
    const int qt = uid >> 2, hh = uid & 3, b = (qt * 128) / SEQL;
    const int tid = F.tid, lane = F.lane, w = F.wave, fr = lane & 15, fq = lane >> 4;
    LAS unsigned char* lds = F.lds;
    const size_t tq = (size_t)qt * 128 + 16 * w + fr;
    const bf16* kvb = KVm + (size_t)(b * MEML) * (2 * DM) + hh * MHD;
#define XA_LOAD(cc, regs) do { const int _col = ((cc) < 8 ? (cc) * 64 : DM + ((cc) - 8) * 64); _Pragma("unroll") for (int _p = 0; _p < 4; ++_p) { const int _row = _p * 64 + (tid >> 3), _ch = tid & 7; \
        regs[_p] = *(const GAS u32x4*)(kvb + (size_t)_row * (2 * DM) + _col + _ch * 8); } } while (0)
#define XA_WRITE(buf, regs) do { _Pragma("unroll") for (int _p = 0; _p < 4; ++_p) { const int _row = _p * 64 + (tid >> 3), _ch = tid & 7; *(LAS u32x4*)(lds + (buf) * XA_BUF + _row * XA_STRIDE + _ch * 16) = regs[_p]; } } while (0)
    u32x4 st[4];
    XA_LOAD(0, st); XA_WRITE(0, st);
    __syncthreads();
    f32x4 S[16];
#pragma unroll
    for (int T = 0; T < 16; ++T) S[T] = (f32x4){0.f, 0.f, 0.f, 0.f};
#pragma unroll 1
    for (int c = 0; c < 8; ++c) {
        XA_LOAD(c + 1, st);
        const bf16x8 q0 = *(const GAS bf16x8*)(Qm + tq * DM + hh * MHD + c * 64 + 8 * fq), q1 = *(const GAS bf16x8*)(Qm + tq * DM + hh * MHD + c * 64 + 32 + 8 * fq);
        LAS unsigned char* kb = lds + (c & 1) * XA_BUF + fr * XA_STRIDE + fq * 16;
#pragma unroll
        for (int T = 0; T < 16; ++T) { const bf16x8 k0 = *(const LAS bf16x8*)(kb + 16 * T * XA_STRIDE), k1 = *(const LAS bf16x8*)(kb + 16 * T * XA_STRIDE + 64);
            S[T] = __builtin_amdgcn_mfma_f32_16x16x32_bf16(k0, q0, S[T], 0, 0, 0); S[T] = __builtin_amdgcn_mfma_f32_16x16x32_bf16(k1, q1, S[T], 0, 0, 0); }
        XA_WRITE((c + 1) & 1, st);
        __syncthreads();
    }
    float mx = -INFINITY;
#pragma unroll
    for (int T = 0; T < 16; ++T)
#pragma unroll
        for (int j = 0; j < 4; ++j) mx = fmaxf(mx, S[T][j]);
    mx = fmaxf(mx, __shfl_xor(mx, 16)); mx = fmaxf(mx, __shfl_xor(mx, 32));
    float sum = 0.f;
#pragma unroll
    for (int T = 0; T < 16; ++T)
#pragma unroll
        for (int j = 0; j < 4; ++j) { const float p = __builtin_amdgcn_exp2f(S[T][j] - mx); S[T][j] = p; sum += p; }
    sum += __shfl_xor(sum, 16); sum += __shfl_xor(sum, 32);
    const float inv = 1.0f / sum;
    bf16x8 pf[8];
#pragma unroll
    for (int s = 0; s < 8; ++s) { u32x4 wv; wv.x = pk2(S[2 * s][0] * inv, S[2 * s][1] * inv); wv.y = pk2(S[2 * s][2] * inv, S[2 * s][3] * inv); wv.z = pk2(S[2 * s + 1][0] * inv, S[2 * s + 1][1] * inv); wv.w = pk2(S[2 * s + 1][2] * inv, S[2 * s + 1][3] * inv); pf[s] = __builtin_bit_cast(bf16x8, wv); }
    const int q4 = fr >> 2, p4 = fr & 3;
#pragma unroll 1
    for (int c = 8; c < 16; ++c) {
        if (c + 1 < 16) XA_LOAD(c + 1, st);
        LAS unsigned char* vb = lds + (c & 1) * XA_BUF + (4 * fq + q4) * XA_STRIDE + p4 * 8;
        f32x4 O[4];
#pragma unroll
        for (int dt = 0; dt < 4; ++dt) O[dt] = (f32x4){0.f, 0.f, 0.f, 0.f};
#pragma unroll
        for (int s = 0; s < 8; ++s)
#pragma unroll
            for (int dt = 0; dt < 4; ++dt) {
                const s16x4 lo = __builtin_amdgcn_ds_read_tr16_b64_v4i16((LAS s16x4*)(vb + (32 * s) * XA_STRIDE + dt * 32));
                const s16x4 hi = __builtin_amdgcn_ds_read_tr16_b64_v4i16((LAS s16x4*)(vb + (32 * s + 16) * XA_STRIDE + dt * 32));
                const bf16x8 vf = {lo[0], lo[1], lo[2], lo[3], hi[0], hi[1], hi[2], hi[3]};
                O[dt] = __builtin_amdgcn_mfma_f32_16x16x32_bf16(vf, pf[s], O[dt], 0, 0, 0); }
        bf16* orow = Om + tq * DM + hh * MHD + (c - 8) * 64 + 4 * fq;
#pragma unroll
        for (int dt = 0; dt < 4; ++dt) { u32x2 o; o.x = pk2(O[dt][0], O[dt][1]); o.y = pk2(O[dt][2], O[dt][3]); *(GAS u32x2*)(orow + 16 * dt) = o; }
        if (c + 1 < 16) XA_WRITE((c + 1) & 1, st);
        __syncthreads();
    }
#undef XA_LOAD
#undef XA_WRITE
}

__device__ __forceinline__ void router_task(Frame& F, const Args& a, int task) {
    const float* x2 = (const float*)(F.ws + WS_X1); const bf16* Wr = (const bf16*)(F.ws + WS_WR); const float* rbias = a.in[15];
    float* gates = (float*)(F.ws + WS_GATES); int* ltok = (int*)(F.ws + WS_LTOK); int* lslot = (int*)(F.ws + WS_LSLOT);
    const int lane = F.lane, fr = lane & 15, fq = lane >> 4, t0 = task * 16;
    f32x4 acc[4];
#pragma unroll
    for (int T = 0; T < 4; ++T) acc[T] = (f32x4){0.f, 0.f, 0.f, 0.f};
    const float* xrow = x2 + (size_t)(t0 + fr) * DM + 8 * fq;
#pragma unroll 2
    for (int ks = 0; ks < DM / 32; ++ks) {
        const f32x4 xa = *(const GAS f32x4*)(xrow + 32 * ks), xb = *(const GAS f32x4*)(xrow + 32 * ks + 4);
        const float xv[8] = {xa.x, xa.y, xa.z, xa.w, xb.x, xb.y, xb.z, xb.w};
        u32x4 hw, lw;
#pragma unroll
        for (int i = 0; i < 4; ++i) { const unsigned h0 = f2bf(xv[2 * i]), h1 = f2bf(xv[2 * i + 1]); hw[i] = h0 | (h1 << 16);
            lw[i] = pk2(xv[2 * i] - __builtin_bit_cast(float, h0 << 16), xv[2 * i + 1] - __builtin_bit_cast(float, h1 << 16)); }
        const bf16x8 xh = __builtin_bit_cast(bf16x8, hw), xl = __builtin_bit_cast(bf16x8, lw);
#pragma unroll
        for (int T = 0; T < 4; ++T) { const bf16* wp = Wr + (size_t)(16 * T + fr) * DM + 32 * ks + 8 * fq;
            const bf16x8 wh = *(const GAS bf16x8*)wp, wl = *(const GAS bf16x8*)(wp + (size_t)NE * DM);
            acc[T] = __builtin_amdgcn_mfma_f32_16x16x32_bf16(wh, xh, acc[T], 0, 0, 0);
            acc[T] = __builtin_amdgcn_mfma_f32_16x16x32_bf16(wh, xl, acc[T], 0, 0, 0);
            acc[T] = __builtin_amdgcn_mfma_f32_16x16x32_bf16(wl, xh, acc[T], 0, 0, 0); }
    }
    LAS float* sc = (LAS float*)(F.lds + F.wave * (2 * 16 * 65 * 4)); LAS float* ch = sc + 16 * 65;
#pragma unroll
    for (int T = 0; T < 4; ++T)
#pragma unroll
        for (int j = 0; j < 4; ++j) { const int e = 16 * T + 4 * fq + j; const float sv = __builtin_amdgcn_rcpf(1.0f + __builtin_amdgcn_exp2f(-1.44269504f * acc[T][j])); sc[fr * 65 + e] = sv; ch[fr * 65 + e] = sv + rbias[e]; }
    LDS_WAIT(); asm volatile("" ::: "memory");
    if (lane < 16) {
        const LAS float* chr = ch + lane * 65; const LAS float* scr = sc + lane * 65; const int t = t0 + lane;
        unsigned gsel = 0u;
        float gs0, gs1, gs2, gs3, gs4, gs5, gs6, gs7;
#define MK_GS(g, dst) { float m1 = -INFINITY, m2 = -INFINITY; for (int i = 0; i < 8; ++i) { const float v = chr[(g) * 8 + i]; if (v > m1) { m2 = m1; m1 = v; } else if (v > m2) m2 = v; } dst = m1 + m2; }
        MK_GS(0, gs0) MK_GS(1, gs1) MK_GS(2, gs2) MK_GS(3, gs3) MK_GS(4, gs4) MK_GS(5, gs5) MK_GS(6, gs6) MK_GS(7, gs7)
#undef MK_GS
        for (int r = 0; r < 4; ++r) { int best = 0; float bv = -INFINITY;
#define MK_PK(g, v) if (!((gsel >> (g)) & 1u) && (v) > bv) { bv = (v); best = (g); }
            MK_PK(0, gs0) MK_PK(1, gs1) MK_PK(2, gs2) MK_PK(3, gs3) MK_PK(4, gs4) MK_PK(5, gs5) MK_PK(6, gs6) MK_PK(7, gs7)
#undef MK_PK
            gsel |= 1u << best; }
        unsigned long long used = 0ull; float wsum = 0.f; int idx[8];
#pragma unroll
        for (int r = 0; r < 8; ++r) { int best = 0; float bv = -INFINITY; for (int e = 0; e < 64; ++e) if (((gsel >> (e >> 3)) & 1u) && !((used >> e) & 1ull) && chr[e] > bv) { bv = chr[e]; best = e; } used |= 1ull << best; wsum += scr[best]; idx[r] = best; }
        const float wn = 2.5f / wsum;
#pragma unroll
        for (int r = 0; r < 8; ++r) { const int e = idx[r]; const int pos = (int)__hip_atomic_fetch_add((unsigned*)(F.ctl + CW_CNT + 64 * e), 1u, RLX_AGENT);
            ltok[e * CAP + pos] = t; lslot[e * CAP + pos] = t * 8 + r; gates[t * 8 + r] = scr[e] * wn; }
    }
    LDS_WAIT(); asm volatile("" ::: "memory");
}

struct GroupOrder {
    volatile LAS unsigned* MISC; const char* Abase; const char* Bbase; size_t Bstride; int K; int nmine; bool gather;
    __device__ __forceinline__ bool next(int i, pg8::Unit& u) const {
        if (i >= nmine) return false;
        const int pk = __builtin_amdgcn_readfirstlane((int)MISC[MW_UL + i]);
        const int e = pk >> 16, rt = (pk >> 4) & 0xfff, pn = pk & 15;
        u.pm = rt; u.pn = pn; u.e = e; u.slot = i;
        u.B = Bbase + (size_t)e * Bstride + (size_t)pn * 256 * K * 2;
        const int rb = __builtin_amdgcn_readfirstlane((int)MISC[MW_RB + e]);
        u.A = gather ? Abase : Abase + ((size_t)rb + (size_t)rt * 256) * K * 2;
        return true;
    }
};
__device__ __forceinline__ int group_setup(Frame& F, int npn, const int* list, int padfill) {
    volatile LAS unsigned* M = F.MISC; LAS int* tab = (LAS int*)(F.lds + TAB_OFF);
    __syncthreads();
    if (F.tid < NEX) { const int c = (F.tid < NE) ? (int)__hip_atomic_load(F.ctl + CW_CNT + 64 * F.tid, RLX_AGENT) : NTOK; M[MW_CNT + F.tid] = (unsigned)c; }
    __syncthreads();
    if (F.tid == 0) { unsigned up = 0, rb = 0; for (int e = 0; e < NEX; ++e) { const unsigned nt = (M[MW_CNT + e] + 255u) >> 8; M[MW_PRE + e] = up; M[MW_RB + e] = rb; up += nt * (unsigned)npn; rb += nt * 256u; } M[MW_PRE + NEX] = up; }
    __syncthreads();
    const int nun = (int)M[MW_PRE + NEX];
    if (F.tid < MAXU) {
        const long L = (long)F.tid * F.G + (int)blockIdx.x; unsigned pk = 0xffffffffu;
        if (L < nun) { int wgid = (int)L; { const int q = nun / 8, r = nun % 8, xcd = wgid % 8, off = wgid / 8; wgid = (xcd < r ? xcd * (q + 1) : r * (q + 1) + (xcd - r) * q) + off; }
            int e = 0; for (int s = 64; s >= 1; s >>= 1) { if (e + s < NEX && (int)M[MW_PRE + e + s] <= wgid) e += s; }
            const int j = wgid - (int)M[MW_PRE + e]; pk = ((unsigned)e << 16) | ((unsigned)(j / npn) << 4) | (unsigned)(j % npn); }
        M[MW_UL + F.tid] = pk;
    }
    __syncthreads();
    int nm = 0; for (int i = 0; i < MAXU; ++i) if (M[MW_UL + i] != 0xffffffffu) nm = i + 1;
    for (int i = 0; i < nm; ++i) { const unsigned pk = M[MW_UL + i]; const int e = (int)(pk >> 16), rt = (int)((pk >> 4) & 0xfff), cnt = (int)M[MW_CNT + e];
        if (F.tid < 256) { const int r = rt * 256 + F.tid; int v = padfill; if (r < cnt) v = (e < NE) ? list[(size_t)e * CAP + r] : r; tab[i * 256 + F.tid] = v; } }
    __syncthreads();
    return nm;
}

__device__ __forceinline__ void final_row(Frame& F, const Args& a, int t) {
    const float* X2 = (const float*)(F.ws + WS_X1);
    const bf16* Y = (const bf16*)(F.ws + WS_Y); const float* gates = (const float*)(F.ws + WS_GATES);
    const float* g = a.in[22]; const float* bta = a.in[23]; float* out = a.out + (size_t)t * DM;
    const int lane = F.lane;
    f32x4 v[8];
#pragma unroll
    for (int j = 0; j < 8; ++j) v[j] = *((const GAS f32x4*)(X2 + (size_t)t * DM) + lane + 64 * j);
#pragma unroll
    for (int k = 0; k < 8; ++k) { const float gk = gates[t * 8 + k]; const GAS u32x2* yr = (const GAS u32x2*)(Y + (size_t)(t * 8 + k) * DM) + lane;
#pragma unroll
        for (int j = 0; j < 8; ++j) { const u32x2 w = yr[64 * j]; v[j].x += gk * bflo(w.x); v[j].y += gk * bfhi(w.x); v[j].z += gk * bflo(w.y); v[j].w += gk * bfhi(w.y); } }
    float s = 0.f;
#pragma unroll
    for (int j = 0; j < 8; ++j) s += (v[j].x + v[j].y) + (v[j].z + v[j].w);
    const float mean = wave_sum(s) * (1.f / DM); float s2 = 0.f;
#pragma unroll
    for (int j = 0; j < 8; ++j) { v[j] = v[j] - mean; s2 += (v[j].x * v[j].x + v[j].y * v[j].y) + (v[j].z * v[j].z + v[j].w * v[j].w); }
    const float rstd = __builtin_amdgcn_rsqf(wave_sum(s2) * (1.f / DM) + LN_EPS);
#pragma unroll
    for (int j = 0; j < 8; ++j) { const f32x4 gg = *((const GAS f32x4*)g + lane + 64 * j), bb = *((const GAS f32x4*)bta + lane + 64 * j); *((GAS f32x4*)out + lane + 64 * j) = v[j] * rstd * gg + bb; }
}

enum { PH_PRO = 0, PH_INPROJ, PH_DATTN, PH_MIX, PH_OUTPROJ, PH_LN1, PH_QPROJ, PH_XATTN, PH_OPROJ, PH_LN2, PH_ROUTE, PH_MOE1, PH_MOE2, PH_FINAL, PH_END };
__global__ void __launch_bounds__(NWAVES * 64, 2) mk_fwd(Args args) {
    extern __shared__ __attribute__((aligned(16))) unsigned char lds_raw[];
    Frame F;
    F.lds = (LAS unsigned char*)lds_raw; F.MISC = (volatile LAS unsigned*)(F.lds + MISC_OFF);
    F.tid = threadIdx.x; F.lane = F.tid & 63; F.wave = __builtin_amdgcn_readfirstlane(F.tid >> 6);
    F.G = gridDim.x; { const int bx = blockIdx.x; F.vcu = (F.G % 8 == 0) ? (bx % 8) * (F.G / 8) + bx / 8 : bx; }
    F.ws = args.ws; F.ctl = (gu32*)(args.ws + WS_CTL);
    for (int u = F.tid; u < MISC_BYTES / 4; u += NWAVES * 64) F.MISC[u] = 0u;
    __syncthreads();
    XcdBarrier bar; bar.bar = (unsigned*)(F.ctl + CW_BAR); bar.x = 0; bar.st = nullptr;
    if (args.use_bar) bar = xcd_barrier_post((unsigned*)(F.ctl + CW_BAR), F.MISC);
    const int lo = args.ph_lo, hi = args.ph_hi;
#define IN(k) (lo <= (k) && (k) < hi)
#define SEAM(k) do { if (IN(k) && IN((k) + 1)) xcd_barrier(bar); } while (0)
    const int gw = F.vcu * NWAVES + F.wave, NGW = F.G * NWAVES;
    LAS const int* tab = (LAS const int*)(F.lds + TAB_OFF);

    if (IN(PH_PRO)) { p0_prologue(F, args); SEAM(PH_PRO); }

    if (IN(PH_INPROJ)) {
        { pg8::DenseOrder S; S.init(F.ws + WS_XB, F.ws + WS_WIN, NTOK, INC, DM, F.G, (int)blockIdx.x);
          pg8::EpiBf16 E{(bf16*)(F.ws + WS_PROJ), AW, AW, (size_t)NTOK * AW, QSCALE};
          pg8::gemm_phase<pg8::EpiBf16, pg8::DenseOrder, false>(F.lds + RING_OFF, DM, S, E, tab); }
        { pg8::DenseOrder S; S.init(F.ws + WS_MB, F.ws + WS_WKV, NB * MEML, 2 * DM, DM, F.G, (int)blockIdx.x);
          pg8::EpiBf16 E{(bf16*)(F.ws + WS_KVM), 2 * DM, 0, 0, 1.0f};
          pg8::gemm_phase<pg8::EpiBf16, pg8::DenseOrder, false>(F.lds + RING_OFF, DM, S, E, tab); }
        SEAM(PH_INPROJ);
    }
    if (IN(PH_DATTN)) { for (int u = F.vcu; u < NB * NH * 96; u += F.G) dattn_unit(F, u); SEAM(PH_DATTN); }
    if (IN(PH_MIX)) { for (int t = gw; t < NTOK; t += NGW) p3_token(F, args, t); SEAM(PH_MIX); }
    if (IN(PH_OUTPROJ)) {
        pg8::DenseOrder S; S.init(F.ws + WS_MIXED, F.ws + WS_WOUT, NTOK, DM, DM, F.G, (int)blockIdx.x);
        pg8::EpiResF32 E{(float*)(F.ws + WS_T), args.in[0], DM, ALPHA};
        pg8::gemm_phase<pg8::EpiResF32, pg8::DenseOrder, false>(F.lds + RING_OFF, DM, S, E, tab);
        SEAM(PH_OUTPROJ);
    }
    if (IN(PH_LN1)) { for (int t = gw; t < NTOK; t += NGW) ln_row((const float*)(F.ws + WS_T) + (size_t)t * DM, args.in[7], args.in[8], (float*)(F.ws + WS_X1) + (size_t)t * DM, (bf16*)(F.ws + WS_X1B) + (size_t)t * DM, F.lane); SEAM(PH_LN1); }
    if (IN(PH_QPROJ)) {
        pg8::DenseOrder S; S.init(F.ws + WS_X1B, F.ws + WS_WQ, NTOK, DM, DM, F.G, (int)blockIdx.x);
        pg8::EpiBf16 E{(bf16*)(F.ws + WS_QM), DM, 0, 0, MQSCALE};
        pg8::gemm_phase<pg8::EpiBf16, pg8::DenseOrder, false>(F.lds + RING_OFF, DM, S, E, tab);
        SEAM(PH_QPROJ);
    }
    if (IN(PH_XATTN)) { for (int u = F.vcu; u < (NTOK / 128) * NMH; u += F.G) xattn_unit(F, u); SEAM(PH_XATTN); }
    if (IN(PH_OPROJ)) {
        pg8::DenseOrder S; S.init(F.ws + WS_OM, F.ws + WS_WO, NTOK, DM, DM, F.G, (int)blockIdx.x);
        pg8::EpiResF32 E{(float*)(F.ws + WS_T), (const float*)(F.ws + WS_X1), DM, ALPHA};
        pg8::gemm_phase<pg8::EpiResF32, pg8::DenseOrder, false>(F.lds + RING_OFF, DM, S, E, tab);
        SEAM(PH_OPROJ);
    }
    if (IN(PH_LN2)) { for (int t = gw; t < NTOK; t += NGW) ln_row((const float*)(F.ws + WS_T) + (size_t)t * DM, args.in[12], args.in[13], (float*)(F.ws + WS_X1) + (size_t)t * DM, (bf16*)(F.ws + WS_X1B) + (size_t)t * DM, F.lane); SEAM(PH_LN2); }
    if (IN(PH_ROUTE)) { for (int task = gw; task < NTOK / 16; task += NGW) router_task(F, args, task); SEAM(PH_ROUTE); }
    if (IN(PH_MOE1)) {
        GroupOrder S; S.MISC = F.MISC; S.Abase = (const char*)(F.ws + WS_X1B); S.Bbase = (const char*)(F.ws + WS_WGU); S.Bstride = (size_t)1024 * DM * 2; S.K = DM; S.gather = true;
        S.nmine = group_setup(F, 4, (const int*)(F.ws + WS_LTOK), 0);
        pg8::EpiSwiGLU E{(bf16*)(F.ws + WS_H), (LAS const int*)(F.lds + MISC_OFF + 4 * MW_RB)};
        pg8::gemm_phase<pg8::EpiSwiGLU, GroupOrder, true>(F.lds + RING_OFF, DM, S, E, tab);
        SEAM(PH_MOE1);
    }
    if (IN(PH_MOE2)) {
        GroupOrder S; S.MISC = F.MISC; S.Abase = (const char*)(F.ws + WS_H); S.Bbase = (const char*)(F.ws + WS_WD); S.Bstride = (size_t)DM * FF * 2; S.K = FF; S.gather = false;
        S.nmine = group_setup(F, 8, (const int*)(F.ws + WS_LSLOT), -1);
        pg8::EpiDown E{(bf16*)(F.ws + WS_Y), (float*)(F.ws + WS_X1), ALPHA, NE};
        pg8::gemm_phase<pg8::EpiDown, GroupOrder, false>(F.lds + RING_OFF, FF, S, E, tab);
        SEAM(PH_MOE2);
    }
    if (IN(PH_FINAL)) { for (int t = gw; t < NTOK; t += NGW) final_row(F, args, t); }
#undef IN
#undef SEAM
}

static int g_grid = 0;
inline bool mk_init() {
    if (g_grid == 0) {
        int dev = 0, cus = 0;
        if (hipGetDevice(&dev) != hipSuccess || hipDeviceGetAttribute(&cus, hipDeviceAttributeMultiprocessorCount, dev) != hipSuccess) { g_grid = -1; return false; }
        if (hipFuncSetAttribute((const void*)mk_fwd, hipFuncAttributeMaxDynamicSharedMemorySize, LDS_BYTES) != hipSuccess) { g_grid = -1; return false; }
        (void)hipGetLastError();
        g_grid = cus;
    }
    return g_grid > 0;
}
inline void mk_run(void* const* d_in, void* d_out, void* d_ws, hipStream_t stream, int lo, int hi, bool per_phase) {
    if (!mk_init()) return;
    Args a{};
    for (int i = 0; i < 24; ++i) a.in[i] = (const float*)d_in[i];
    a.out = (float*)d_out; a.ws = (unsigned char*)d_ws;
    if (per_phase) { for (int p = lo; p < hi; ++p) { a.ph_lo = p; a.ph_hi = p + 1; a.use_bar = 0; hipLaunchKernelGGL(mk_fwd, dim3(g_grid), dim3(NWAVES * 64), LDS_BYTES, stream, a); } }
    else { a.ph_lo = lo; a.ph_hi = hi; a.use_bar = 1; hipLaunchKernelGGL(mk_fwd, dim3(g_grid), dim3(NWAVES * 64), LDS_BYTES, stream, a); }
}
}
extern "C" void kernel_launch(void* const* d_in, const int* in_sizes, int n_in, void* d_out, int out_size, void* d_ws, size_t ws_size, hipStream_t stream) {
    (void)in_sizes; (void)n_in; (void)out_size; (void)ws_size;
    (void)hipMemsetAsync((char*)d_ws + mk::WS_CTL, 0, mk::CTL_ZERO_BYTES, stream);
    mk::mk_run(d_in, d_out, d_ws, stream, 0, mk::PH_END, false);
}
```

```cpp
#include <hip/hip_runtime.h>
#include <cstdio>
#include <cstdint>
#include <cmath>
namespace pg8 {
#define PG8_LAS __attribute__((address_space(3)))
typedef unsigned short bf16_t;
typedef short bf16x8 __attribute__((ext_vector_type(8)));
typedef float f32x4 __attribute__((ext_vector_type(4)));
typedef float f32x2 __attribute__((ext_vector_type(2)));
typedef unsigned u32x4 __attribute__((ext_vector_type(4)));
typedef unsigned u32x2 __attribute__((ext_vector_type(2)));
typedef int i32x4 __attribute__((ext_vector_type(4)));
typedef int i32x8 __attribute__((ext_vector_type(8)));
constexpr int BM = 256, BK = 64, HALF = 128, HTB = HALF * BK * 2  , STAGE_BYTES = 8 * HTB, NXCD = 8, WGM = 8;

__host__ __device__ __forceinline__ int lds_byte(int r, int c) { const int st = (r >> 4) * 2 + (c >> 5), rr = r & 15, cc = c & 31, ob = rr * 64 + cc * 2; return st * 1024 + (ob ^ (((ob >> 9) & 1) << 5)); }
__host__ __device__ __forceinline__ void stage_rc(int b, int& R, int& C) { const int st = b / 1024, sb = b % 1024, swz = sb ^ (((sb >> 9) & 1) << 5); R = (st >> 1) * 16 + swz / 64; C = (st & 1) * 32 + (swz % 64) / 2; }
__host__ __device__ __forceinline__ int perm32(int rho) { const int n = rho >> 4, i = rho & 15; return 8 * (i >> 2) + 4 * n + (i & 3); }

struct Unit { int pm, pn; const char* A; const char* B; int e; int slot; };

struct DenseOrder {
    const char* A; const char* Bt; int K; int nM, nN, nwg, G, c;
    __device__ void init(const void* A_, const void* Bt_, int M, int N, int K_, int G_, int c_) { A = (const char*)A_; Bt = (const char*)Bt_; K = K_; nM = M / BM; nN = N / BM; nwg = nM * nN; G = G_; c = c_; }
    __device__ __forceinline__ bool next(int i, Unit& u) const {
        const long L = (long)i * G + c; if (L >= nwg) return false;
        int wgid = (int)L; { const int q = nwg / NXCD, r = nwg % NXCD, xcd = wgid % NXCD, off = wgid / NXCD; wgid = (xcd < r ? xcd * (q + 1) : r * (q + 1) + (xcd - r) * q) + off; }
        const int nig = WGM * nN, gid = wgid / nig, fm = gid * WGM, gsz = (nM - fm) < WGM ? (nM - fm) : WGM;
        u.pm = fm + ((wgid % nig) % gsz); u.pn = (wgid % nig) / gsz;
        u.A = A + (size_t)u.pm * BM * K * 2; u.B = Bt + (size_t)u.pn * BM * K * 2; u.e = 0; u.slot = i; return true;
    }
};

typedef __bf16 bf16x2_t __attribute__((ext_vector_type(2)));
__device__ __forceinline__ unsigned pk4_fp8(float a, float b, float c, float d) { int w = __builtin_amdgcn_cvt_pk_fp8_f32(a, b, 0, false); w = __builtin_amdgcn_cvt_pk_fp8_f32(c, d, w, true); return (unsigned)w; }
__device__ __forceinline__ unsigned cvt_pk_bf16(float lo, float hi) { const f32x2 v = {lo, hi}; const bf16x2_t r = __builtin_convertvector(v, bf16x2_t); return __builtin_bit_cast(unsigned, r); }

struct EpiBf16 {
    static constexpr bool PERM = true;
    bf16_t* O; int ldc; int split_cols; size_t split_stride; float scale0;
    __device__ __forceinline__ void operator()(const f32x4 (&acc)[2][2][4][2], const Unit& u, int wr, int wc, int fr, int fq, PG8_LAS const int* tab) const {
        const int row0 = u.pm * BM + wr * 64 + fr; int colt = u.pn * BM; bf16_t* base = O;
        float sc = scale0; if (split_cols) { const int t = colt / split_cols; base += (size_t)t * split_stride; colt -= t * split_cols; if (t != 0) sc = 1.f; }
        const int col0 = colt + wc * 32 + 8 * fq;
#pragma unroll
        for (int ai = 0; ai < 2; ++ai)
#pragma unroll
            for (int m = 0; m < 4; ++m) { bf16_t* rowp = base + (size_t)(row0 + ai * HALF + m * 16) * ldc + col0;
#pragma unroll
                for (int bj = 0; bj < 2; ++bj) { f32x4 v0 = acc[ai][bj][m][0] * sc, v1 = acc[ai][bj][m][1] * sc;
                    u32x4 w; w.x = cvt_pk_bf16(v0[0], v0[1]); w.y = cvt_pk_bf16(v0[2], v0[3]); w.z = cvt_pk_bf16(v1[0], v1[1]); w.w = cvt_pk_bf16(v1[2], v1[3]);
                    *(u32x4*)(rowp + bj * HALF) = w; } }
    }
};
struct EpiResF32 {
    static constexpr bool PERM = false;
    float* C; const float* R; int ldc; float alpha;
    __device__ __forceinline__ void operator()(const f32x4 (&acc)[2][2][4][2], const Unit& u, int wr, int wc, int fr, int fq, PG8_LAS const int* tab) const {
        const int row0 = u.pm * BM + wr * 64 + fr, col0 = u.pn * BM + wc * 32 + 4 * fq;
#pragma unroll
        for (int ai = 0; ai < 2; ++ai)
#pragma unroll
            for (int m = 0; m < 4; ++m) { const size_t off = (size_t)(row0 + ai * HALF + m * 16) * ldc + col0;
#pragma unroll
                for (int bj = 0; bj < 2; ++bj)
#pragma unroll
                    for (int n = 0; n < 2; ++n) { const f32x4 r = *(const f32x4*)(R + off + bj * HALF + n * 16); *(f32x4*)(C + off + bj * HALF + n * 16) = r * alpha + acc[ai][bj][m][n]; }
                asm volatile("" ::: "memory"); }
    }
};
struct EpiSwiGLU {
    static constexpr bool PERM = true;
    unsigned char* Hq; PG8_LAS const int* rowbase; float wscale;
    __device__ __forceinline__ void operator()(const f32x4 (&acc)[2][2][4][2], const Unit& u, int wr, int wc, int fr, int fq, PG8_LAS const int* tab) const {
        const int rb = __builtin_amdgcn_readfirstlane(rowbase[u.e]);
        const size_t row0 = (size_t)rb + u.pm * BM + wr * 64 + fr; const int col0 = u.pn * HALF + wc * 32 + 8 * fq;
#pragma unroll
        for (int ai = 0; ai < 2; ++ai)
#pragma unroll
            for (int m = 0; m < 4; ++m) { unsigned char* rowp = Hq + (row0 + ai * HALF + m * 16) * 512 + col0;
                float hv[8];
#pragma unroll
                for (int n = 0; n < 2; ++n)
#pragma unroll
                    for (int j = 0; j < 4; ++j) { const float g = acc[ai][0][m][n][j] * wscale, uu = acc[ai][1][m][n][j] * wscale;
                        hv[n * 4 + j] = g * __builtin_amdgcn_rcpf(1.0f + __builtin_amdgcn_exp2f(-1.44269504f * g)) * uu; }
                u32x2 w; w.x = pk4_fp8(hv[0], hv[1], hv[2], hv[3]); w.y = pk4_fp8(hv[4], hv[5], hv[6], hv[7]);
                *(u32x2*)rowp = w; }
    }
};
struct EpiDown {
    static constexpr bool PERM = true;
    bf16_t* Y; float* X2; float alpha; int nsh; int dry; float wscale;
    __device__ __forceinline__ void operator()(const f32x4 (&acc)[2][2][4][2], const Unit& u, int wr, int wc, int fr, int fq, PG8_LAS const int* tab) const {
        const int col0 = u.pn * BM + wc * 32 + 8 * fq;
        if (u.e == nsh) {
            const int row0 = u.pm * BM + wr * 64 + fr;
#pragma unroll
            for (int ai = 0; ai < 2; ++ai)
#pragma unroll
                for (int m = 0; m < 4; ++m) { float* rowp = X2 + (size_t)(row0 + ai * HALF + m * 16) * 2048 + col0;
#pragma unroll
                    for (int bj = 0; bj < 2; ++bj)
#pragma unroll
                        for (int n = 0; n < 2; ++n) { const f32x4 r = *(const f32x4*)(rowp + bj * HALF + 4 * n); if (!dry) *(f32x4*)(rowp + bj * HALF + 4 * n) = r * alpha + acc[ai][bj][m][n] * wscale; }
                    asm volatile("" ::: "memory"); }
        } else {
#pragma unroll
            for (int ai = 0; ai < 2; ++ai)
#pragma unroll
                for (int m = 0; m < 4; ++m) { const int dst = tab[u.slot * 256 + ai * HALF + wr * 64 + m * 16 + fr];
                    if (dst >= 0) { bf16_t* rowp = Y + (size_t)dst * 2048 + col0;
#pragma unroll
                        for (int bj = 0; bj < 2; ++bj) { const f32x4 v0 = acc[ai][bj][m][0] * wscale, v1 = acc[ai][bj][m][1] * wscale;
                            u32x4 w; w.x = cvt_pk_bf16(v0[0], v0[1]); w.y = cvt_pk_bf16(v0[2], v0[3]); w.z = cvt_pk_bf16(v1[0], v1[1]); w.w = cvt_pk_bf16(v1[2], v1[3]);
                            *(u32x4*)(rowp + bj * HALF) = w; } } }
        }
    }
};

__device__ __forceinline__ int fresh_lane() { int l; asm volatile("v_mbcnt_lo_u32_b32 %0, -1, 0\n\tv_mbcnt_hi_u32_b32 %0, -1, %0" : "=v"(l)); return l; }
template <class Epi, class Sched, bool GATHER, bool F8 = false>
__device__ __forceinline__ void gemm_phase(PG8_LAS unsigned char* lds, const int K, const Sched& S, const Epi& E, PG8_LAS const int* tab, const int wid  ) {
    const int lane = fresh_lane(), tid = wid * 64 + lane, wr = wid >> 2, wc = wid & 3, fr = lane & 15, fq = lane >> 4;
    const int nt = K / BK;
    unsigned voffB[2];
#pragma unroll
    for (int i = 0; i < 2; ++i) { int R, C; stage_rc(tid * 16 + i * 8192, R, C); const int Rb = Epi::PERM ? ((R & ~31) + perm32(R & 31)) : R; voffB[i] = (unsigned)(Rb * K + C) * 2u; }
    const size_t kstep = (size_t)(BK * 2);
    const size_t hstep = (size_t)HALF * K * 2;
    const size_t hA1 = GATHER ? (size_t)0 : hstep;
    const unsigned ldsw = (unsigned)wid * 1024u;
    const int aoff = lds_byte(wr * 64 + fr, fq * 8), boff = lds_byte(wc * 32 + fr, fq * 8);
#define PG8_SA(b, h) (((b) * 2 + (h)) * HTB)
#define PG8_SB(b, h) ((4 + (b) * 2 + (h)) * HTB)
#define PG8_STAGE(bufoff, gbase, voff) do { _Pragma("unroll") for (int _i = 0; _i < 2; ++_i) { unsigned _o = (voff)[_i]; asm volatile("" : "+v"(_o)); \
        __builtin_amdgcn_global_load_lds((const unsigned*)((const char*)(gbase) + _o), (PG8_LAS unsigned*)(lds + (bufoff) + ldsw + _i * 8192), 16, 0, 0); } } while (0)
#define PG8_LDA(dst, b, h) do { if constexpr (F8) { _Pragma("unroll") for (int m = 0; m < 4; ++m) { const i32x4 _p0 = *(const PG8_LAS i32x4*)(lds + PG8_SA(b, h) + aoff + m * 2048), _p1 = *(const PG8_LAS i32x4*)(lds + PG8_SA(b, h) + aoff + m * 2048 + 1024); dst##8[m] = __builtin_shufflevector(_p0, _p1, 0, 1, 2, 3, 4, 5, 6, 7); } } \
        else { _Pragma("unroll") for (int m = 0; m < 4; ++m) _Pragma("unroll") for (int k = 0; k < 2; ++k) dst[m][k] = *(const PG8_LAS bf16x8*)(lds + PG8_SA(b, h) + aoff + m * 2048 + k * 1024); } } while (0)
#define PG8_LDB(dst, b, h) do { if constexpr (F8) { _Pragma("unroll") for (int n = 0; n < 2; ++n) { const i32x4 _p0 = *(const PG8_LAS i32x4*)(lds + PG8_SB(b, h) + boff + n * 2048), _p1 = *(const PG8_LAS i32x4*)(lds + PG8_SB(b, h) + boff + n * 2048 + 1024); dst##8[n] = __builtin_shufflevector(_p0, _p1, 0, 1, 2, 3, 4, 5, 6, 7); } } \
        else { _Pragma("unroll") for (int n = 0; n < 2; ++n) _Pragma("unroll") for (int k = 0; k < 2; ++k) dst[n][k] = *(const PG8_LAS bf16x8*)(lds + PG8_SB(b, h) + boff + n * 2048 + k * 1024); } } while (0)
#define PG8_MMA(ai, bj, At, Bt) do { __builtin_amdgcn_s_setprio(1); _Pragma("unroll") for (int m = 0; m < 4; ++m) _Pragma("unroll") for (int n = 0; n < 2; ++n) { \
        if constexpr (F8) acc[ai][bj][m][n] = __builtin_amdgcn_mfma_scale_f32_16x16x128_f8f6f4(Bt##8[n], At##8[m], acc[ai][bj][m][n], 0, 0, 0, 0x7f7f7f7f, 0, 0x7f7f7f7f); \
        else { _Pragma("unroll") for (int k = 0; k < 2; ++k) acc[ai][bj][m][n] = __builtin_amdgcn_mfma_f32_16x16x32_bf16(Bt[n][k], At[m][k], acc[ai][bj][m][n], 0, 0, 0); } } \
        __builtin_amdgcn_s_setprio(0); } while (0)
#define PG8_WAIT_V(n) asm volatile("s_waitcnt vmcnt(" #n ")" ::: "memory")
#define PG8_WAIT_L(n) asm volatile("s_waitcnt lgkmcnt(" #n ")" ::: "memory")
#define PG8_BAR __builtin_amdgcn_s_barrier()
#define PG8_SCHED __builtin_amdgcn_sched_barrier(0)
#define PG8_VOFF(u, v) do { const int _tid = wid * 64 + fresh_lane(); _Pragma("unroll") for (int _i = 0; _i < 2; ++_i) { int _R, _C; stage_rc(_tid * 16 + _i * 8192, _R, _C); _Pragma("unroll") for (int _h = 0; _h < 2; ++_h) { \
        if (GATHER) { const int _row = tab[(u).slot * 256 + _h * HALF + _R]; v[_h][_i] = (unsigned)_row * (unsigned)(K * 2) + (unsigned)(_C * 2); } \
        else v[_h][_i] = (unsigned)(_R * K + _C) * 2u; } } } while (0)
    Unit cur, nxt; int ui = 0;
    if (!S.next(0, cur)) return;
    f32x4 acc[2][2][4][2];
#pragma unroll
    for (int a = 0; a < 2; ++a)
#pragma unroll
        for (int b = 0; b < 2; ++b)
#pragma unroll
            for (int m = 0; m < 4; ++m)
#pragma unroll
                for (int n = 0; n < 2; ++n) acc[a][b][m][n] = (f32x4){0.f, 0.f, 0.f, 0.f};
    bf16x8 At[4][2], B0[2][2], B1[2][2]; i32x8 At8[4], B08[2], B18[2];
    unsigned vA[2][2];
    PG8_VOFF(cur, vA);
    if (GATHER) PG8_WAIT_L(0);
    const char* cA = cur.A; const char* cB = cur.B;
    PG8_STAGE(PG8_SB(0, 0), cB, voffB); PG8_STAGE(PG8_SB(0, 1), cB + hstep, voffB); PG8_STAGE(PG8_SA(0, 0), cA, vA[0]); PG8_STAGE(PG8_SA(0, 1), cA + hA1, vA[1]);
    if (wr == 1) PG8_BAR;
    PG8_WAIT_V(2); PG8_BAR;
    PG8_STAGE(PG8_SB(1, 0), cB + kstep, voffB); PG8_STAGE(PG8_SA(1, 0), cA + kstep, vA[0]); PG8_STAGE(PG8_SB(1, 1), cB + hstep + kstep, voffB);
    PG8_WAIT_V(6); PG8_BAR;
    for (;;) {
        const bool has_next = S.next(ui + 1, nxt);
        const char* nA = has_next ? nxt.A : cA; const char* nB = has_next ? nxt.B : cB;
#pragma nounroll
        for (int t = 0; t < nt; t += 2) {
            const bool last = (t == nt - 2);
            const char* a1 = cA + (size_t)(t + 1) * kstep;
            const char* a2 = last ? nA : cA + (size_t)(t + 2) * kstep; const char* b2 = last ? nB : cB + (size_t)(t + 2) * kstep;
            const char* a3 = a2 + kstep; const char* b3 = b2 + kstep;
            unsigned w0[2], w1[2];
            if (GATHER && last && has_next) { unsigned vN[2][2]; PG8_VOFF(nxt, vN); w0[0] = vN[0][0]; w0[1] = vN[0][1]; w1[0] = vN[1][0]; w1[1] = vN[1][1]; }
            else { w0[0] = vA[0][0]; w0[1] = vA[0][1]; w1[0] = vA[1][0]; w1[1] = vA[1][1]; }
            PG8_LDB(B0, 0, 0); PG8_LDB(B1, 0, 1); PG8_SCHED; PG8_LDA(At, 0, 0); PG8_STAGE(PG8_SA(1, 1), a1 + hA1, vA[1]);
            PG8_WAIT_V(8); PG8_WAIT_L(0); PG8_BAR; PG8_MMA(0, 0, At, B0); PG8_MMA(0, 1, At, B1); PG8_BAR; PG8_SCHED;
            PG8_LDA(At, 0, 1); PG8_STAGE(PG8_SB(0, 0), b2, voffB); PG8_STAGE(PG8_SB(0, 1), b2 + hstep, voffB); PG8_STAGE(PG8_SA(0, 0), a2, w0);
            PG8_WAIT_V(8); PG8_WAIT_L(0); PG8_BAR; PG8_MMA(1, 0, At, B0); PG8_MMA(1, 1, At, B1); PG8_BAR; PG8_SCHED;
            PG8_LDB(B0, 1, 0); PG8_LDB(B1, 1, 1); PG8_SCHED; PG8_LDA(At, 1, 0); PG8_STAGE(PG8_SA(0, 1), a2 + hA1, w1);
            PG8_WAIT_V(8); PG8_WAIT_L(0); PG8_BAR; PG8_MMA(0, 0, At, B0); PG8_MMA(0, 1, At, B1); PG8_BAR; PG8_SCHED;
            PG8_LDA(At, 1, 1); PG8_STAGE(PG8_SB(1, 0), b3, voffB); PG8_STAGE(PG8_SB(1, 1), b3 + hstep, voffB); PG8_STAGE(PG8_SA(1, 0), a3, w0);
            PG8_WAIT_V(8); PG8_WAIT_L(0); PG8_BAR; PG8_MMA(1, 0, At, B0); PG8_MMA(1, 1, At, B1); PG8_BAR; PG8_SCHED;
        }
        if (wr == 0) PG8_BAR;
        { const int _l = fresh_lane(); E(acc, cur, wr, wc, _l & 15, _l >> 4, tab); }
        if (!has_next) break;
#pragma unroll
        for (int a = 0; a < 2; ++a)
#pragma unroll
            for (int b = 0; b < 2; ++b)
#pragma unroll
                for (int m = 0; m < 4; ++m)
#pragma unroll
                    for (int n = 0; n < 2; ++n) acc[a][b][m][n] = (f32x4){0.f, 0.f, 0.f, 0.f};
        cur = nxt; cA = nA; cB = nB; ++ui;
        if (GATHER) PG8_VOFF(cur, vA);
        if (wr == 1) PG8_BAR;
    }
    PG8_WAIT_V(0);
    PG8_BAR;
#undef PG8_SA
#undef PG8_SB
#undef PG8_STAGE
#undef PG8_LDA
#undef PG8_LDB
#undef PG8_MMA
#undef PG8_WAIT_V
#undef PG8_WAIT_L
#undef PG8_BAR
#undef PG8_SCHED
#undef PG8_VOFF
}
}
namespace mk {
#define GAS __attribute__((address_space(1)))
#define LAS __attribute__((address_space(3)))
typedef unsigned short bf16;
typedef unsigned u32x4 __attribute__((ext_vector_type(4)));
typedef unsigned u32x2 __attribute__((ext_vector_type(2)));
typedef float f32x4 __attribute__((ext_vector_type(4)));
typedef short bf16x8 __attribute__((ext_vector_type(8)));
typedef short s16x4 __attribute__((ext_vector_type(4)));
typedef GAS unsigned gu32;
#define RLX_AGENT __ATOMIC_RELAXED, __HIP_MEMORY_SCOPE_AGENT
#define LDS_WAIT() asm volatile("s_waitcnt lgkmcnt(0)" ::: "memory")
#define VM_WAIT() asm volatile("s_waitcnt vmcnt(0)" ::: "memory")

constexpr int NWAVES = 8;
constexpr int NTOK = 16384, DM = 2048, SEQL = 4096, NB = 4, AW = 1024, HD = 128, NH = 8, INC = 6144;
constexpr int MEML = 256, NMH = 4, MHD = 512, NE = 64, NEX = 65  , TOPK = 8, FF = 512, CAP = 16384;
constexpr float LN_EPS = 1e-5f, RMS_EPS = 1e-6f, ALPHA = 1.189207115002721f;
constexpr float QSCALE = 0.08838834764831845f * 1.4426950408889634f;
constexpr float MQSCALE = 0.04419417382415922f * 1.4426950408889634f;
constexpr float WPRE = 32.0f, WPOST = 1.0f / 32.0f;
constexpr int HROWS = 131072 + 64 * 256 + 16384;

constexpr size_t MiB = 1u << 20;
constexpr size_t WS_CTL = 0, CTL_ZERO_BYTES = 1 * MiB;
constexpr size_t WS_WD = 2 * MiB;
constexpr size_t WS_WGU = 132 * MiB;
constexpr size_t WS_Y = 132 * MiB;
constexpr size_t WS_WIN = 392 * MiB, WS_WOUT = 416 * MiB, WS_WQ = 424 * MiB, WS_WKV = 432 * MiB, WS_WO = 448 * MiB, WS_WR = 456 * MiB;
constexpr size_t WS_OG = 457 * MiB;
constexpr size_t WS_QM = 457 * MiB, WS_OM = 521 * MiB;
constexpr size_t WS_MIXED = 553 * MiB;
constexpr size_t WS_XB = 644 * MiB, WS_MB = 708 * MiB;
constexpr size_t WS_T = 644 * MiB;
constexpr size_t WS_H = 644 * MiB;
constexpr size_t WS_PROJ = 804 * MiB;
constexpr size_t WS_X1 = 804 * MiB;
constexpr size_t WS_X1B = 932 * MiB;
constexpr size_t WS_KVM = 996 * MiB;
constexpr size_t WS_LSE = 1004 * MiB;
constexpr size_t WS_GATES = 1006 * MiB;
constexpr size_t WS_LTOK = 1007 * MiB, WS_LSLOT = 1011 * MiB;
constexpr size_t WS_END = 1016 * MiB;
constexpr int CW_TMO = 0, CW_CODE = 1, CW_BAR = 4096, CW_CNT = 16384;

constexpr int RING_OFF = 0, RING_BYTES = 131072, TAB_OFF = 131072, TAB_BYTES = 24576, MISC_OFF = TAB_OFF + TAB_BYTES, MISC_BYTES = 2048;
constexpr int LDS_BYTES = MISC_OFF + MISC_BYTES;
constexpr int MAXU = 24;
constexpr int MW_PRE = 16, MW_RB = 96, MW_CNT = 176, MW_UL = 256, MW_NM = 300;

__device__ __forceinline__ unsigned f2bf(float f) { unsigned u = __builtin_bit_cast(unsigned, f); return (u + 0x7fffu + ((u >> 16) & 1u)) >> 16; }
__device__ __forceinline__ unsigned pk2(float lo, float hi) { return pg8::cvt_pk_bf16(lo, hi); }
__device__ __forceinline__ float bf2f(unsigned short b) { return __builtin_bit_cast(float, (unsigned)b << 16); }
__device__ __forceinline__ float bflo(unsigned w) { return __builtin_bit_cast(float, w << 16); }
__device__ __forceinline__ float bfhi(unsigned w) { return __builtin_bit_cast(float, w & 0xffff0000u); }

#define XB_TMO      128
#define XB_XCNT(j)  (256  + 64 * (j))
#define XB_XSUB(j)  (1280 + 64 * (j))
#define XB_XGEN(j)  (2304 + 64 * (j))
#define XB_TOP      3328
#define XB_TOPGEN   3392
#define XCD_BAR_WORDS 3456
#define XB_SPIN_CAP (1u << 18)
__device__ __forceinline__ unsigned xb_ld(unsigned* p)              { return __hip_atomic_load(p, __ATOMIC_RELAXED, __HIP_MEMORY_SCOPE_AGENT); }
__device__ __forceinline__ unsigned xb_add(unsigned* p, unsigned v) { return __hip_atomic_fetch_add(p, v, __ATOMIC_RELAXED, __HIP_MEMORY_SCOPE_AGENT); }
__device__ __forceinline__ unsigned xb_xcc_id() { return (unsigned)__builtin_amdgcn_s_getreg((3 << 11) | 20) & 0xFu; }
#define XB_SPIN(cond, bar) do { unsigned _sp = 0; while (cond) { __builtin_amdgcn_s_sleep(1); \
    if ((++_sp & 255u) == 0u) { if (xb_ld(&(bar)[XB_TMO])) break; if (_sp > XB_SPIN_CAP) { atomicAdd(&(bar)[XB_TMO], 1u); break; } } } } while (0)
struct XcdBarrier { unsigned* bar; unsigned x; volatile LAS unsigned* st; int wave; };
__device__ __forceinline__ bool xb_thread0(int wave) { return wave == 0 && pg8::fresh_lane() == 0; }
__device__ __forceinline__ XcdBarrier xcd_barrier_post(unsigned* bar, volatile LAS unsigned* st, int wave) {
    XcdBarrier b; b.bar = bar; b.x = xb_xcc_id(); b.st = st; b.wave = wave;
    if (xb_thread0(wave)) (void)xb_add(&bar[XB_XCNT(b.x)], 1u);
    return b;
}
__device__ __forceinline__ void xcd_barrier_complete(unsigned* bar, unsigned x, unsigned& nloc, unsigned& nx) {
    const unsigned G = gridDim.x * gridDim.y * gridDim.z;
    unsigned sum, cnt, mine, sp = 0u;
    for (;;) {
        sum = 0u; cnt = 0u; mine = 0u;
#pragma unroll
        for (unsigned j = 0; j < 16; ++j) { const unsigned c = xb_ld(&bar[XB_XCNT(j)]); sum += c; cnt += (c > 0u) ? 1u : 0u; mine = (j == x) ? c : mine; }
        if (sum == G) break;
        __builtin_amdgcn_s_sleep(1);
        if ((++sp & 255u) == 0u) { if (xb_ld(&bar[XB_TMO])) break; if (sp > XB_SPIN_CAP) { atomicAdd(&bar[XB_TMO], 1u); break; } }
    }
    nloc = mine > 0u ? mine : 1u; nx = cnt > 0u ? cnt : 1u;
}
__device__ __forceinline__ void xcd_barrier(const XcdBarrier& b) {
    asm volatile("s_waitcnt vmcnt(0)" ::: "memory");
    __syncthreads();
    if (xb_thread0(b.wave)) {
        unsigned* bar = b.bar;
        __builtin_amdgcn_s_waitcnt(0);
        unsigned nloc = b.st[0], nx = b.st[1];
        if (nloc == 0u) { xcd_barrier_complete(bar, b.x, nloc, nx); b.st[0] = nloc; b.st[1] = nx; }
        const unsigned old = xb_add(&bar[XB_XSUB(b.x)], 1u);
        const unsigned gen = old / nloc;
        if (old + 1u == (gen + 1u) * nloc) {
            __builtin_amdgcn_fence(__ATOMIC_RELEASE, "agent");
            asm volatile("s_waitcnt vmcnt(0)" ::: "memory");
            const unsigned og = xb_add(&bar[XB_TOP], 1u);
            const unsigned tg = og / nx;
            if (og + 1u == (tg + 1u) * nx) xb_add(&bar[XB_TOPGEN], 1u);
            else XB_SPIN(xb_ld(&bar[XB_TOPGEN]) == tg, bar);
            __builtin_amdgcn_fence(__ATOMIC_ACQUIRE, "agent");
            xb_add(&bar[XB_XGEN(b.x)], 1u);
            asm volatile("s_waitcnt vmcnt(0)" ::: "memory");
        } else {
            XB_SPIN(xb_ld(&bar[XB_XGEN(b.x)]) == gen, bar);
            __builtin_amdgcn_fence(__ATOMIC_ACQUIRE, "agent");
            asm volatile("s_waitcnt vmcnt(0)" ::: "memory");
        }
    }
    __syncthreads();
}

struct Args { const float* in[24]; float* out; unsigned char* ws; int ph_lo, ph_hi, use_bar, pad; };
struct Frame {
    LAS unsigned char* lds; volatile LAS unsigned* MISC; gu32* ctl; unsigned char* ws;
    int wave, vcu, G;
    __device__ __forceinline__ int lane_() const { return pg8::fresh_lane(); }
};
#define F_LANE(F) ((F).lane_())
#define F_TID(F) ((F).wave * 64 + (F).lane_())
__device__ __forceinline__ float wave_sum(float v) {
#pragma unroll
    for (int o = 1; o < 64; o <<= 1) v += __shfl_xor(v, o);
    return v;
}

__device__ __forceinline__ void p0_tr_item(const float* W, int ldw, int K, bf16* WT, int k0, int n0, int drow0, LAS float* scr, int lane) {
    f32x4 v[16];
    const float* src = W + (size_t)(k0 + (lane >> 4)) * ldw + n0 + 4 * (lane & 15);
#pragma unroll
    for (int p = 0; p < 16; ++p) v[p] = __builtin_nontemporal_load((const GAS f32x4*)(src + (size_t)(p * 4) * ldw));
#pragma unroll
    for (int p = 0; p < 16; ++p) { const int kk = p * 4 + (lane >> 4); LAS float* d = scr + kk * 65 + 4 * (lane & 15); d[0] = v[p].x; d[1] = v[p].y; d[2] = v[p].z; d[3] = v[p].w; }
    LDS_WAIT(); asm volatile("" ::: "memory");
    const int c = lane & 7;
#pragma unroll
    for (int j = 0; j < 8; ++j) { const int n = (lane >> 3) + 8 * j; const LAS float* s = scr + (8 * c) * 65 + n;
        u32x4 o; o.x = pk2(s[0 * 65], s[1 * 65]); o.y = pk2(s[2 * 65], s[3 * 65]); o.z = pk2(s[4 * 65], s[5 * 65]); o.w = pk2(s[6 * 65], s[7 * 65]);
        *(GAS u32x4*)(WT + (size_t)(drow0 + n) * K + k0 + 8 * c) = o; }
    LDS_WAIT(); asm volatile("" ::: "memory");
}
__device__ __forceinline__ void p0_tr_item_f8(const float* W, int ldw, int K, unsigned char* WT, int k0, int n0, int drow0, LAS float* scr, int lane, float scale) {
    f32x4 v[16];
    const float* src = W + (size_t)(k0 + (lane >> 4)) * ldw + n0 + 4 * (lane & 15);
#pragma unroll
    for (int p = 0; p < 16; ++p) v[p] = __builtin_nontemporal_load((const GAS f32x4*)(src + (size_t)(p * 4) * ldw));
#pragma unroll
    for (int p = 0; p < 16; ++p) { const int kk = p * 4 + (lane >> 4); LAS float* d = scr + kk * 65 + 4 * (lane & 15); d[0] = v[p].x * scale; d[1] = v[p].y * scale; d[2] = v[p].z * scale; d[3] = v[p].w * scale; }
    LDS_WAIT(); asm volatile("" ::: "memory");
    const int c = lane & 3;
#pragma unroll
    for (int j = 0; j < 4; ++j) { const int n = (lane >> 2) + 16 * j; const LAS float* s = scr + (16 * c) * 65 + n;
        u32x4 o; o.x = pg8::pk4_fp8(s[0 * 65], s[1 * 65], s[2 * 65], s[3 * 65]); o.y = pg8::pk4_fp8(s[4 * 65], s[5 * 65], s[6 * 65], s[7 * 65]);
        o.z = pg8::pk4_fp8(s[8 * 65], s[9 * 65], s[10 * 65], s[11 * 65]); o.w = pg8::pk4_fp8(s[12 * 65], s[13 * 65], s[14 * 65], s[15 * 65]);
        *(GAS u32x4*)(WT + (size_t)(drow0 + n) * K + k0 + 16 * c) = o; }
    LDS_WAIT(); asm volatile("" ::: "memory");
}
__device__ __forceinline__ void p0_prologue(Frame& F, const Args& a) {
    const int f_lane = F_LANE(F), f_tid = F.wave * 64 + f_lane; (void)f_tid;
    LAS float* scr = (LAS float*)(F.lds + F.wave * 16640);
    const int gw = F.vcu * NWAVES + F.wave, NGW = F.G * NWAVES;
    const float* x = a.in[0]; const float* mem = a.in[1]; const float* w_in = a.in[2]; const float* w_out = a.in[6]; const float* wq = a.in[9]; const float* wkv = a.in[10]; const float* wo = a.in[11];
    const float* wr = a.in[14]; const float* wg = a.in[16]; const float* wu = a.in[17]; const float* wd = a.in[18]; const float* wsg = a.in[19]; const float* wsu = a.in[20]; const float* wsd = a.in[21];
    bf16* Win_t = (bf16*)(F.ws + WS_WIN); bf16* Wout_t = (bf16*)(F.ws + WS_WOUT); bf16* Wq_t = (bf16*)(F.ws + WS_WQ); bf16* Wkv_t = (bf16*)(F.ws + WS_WKV); bf16* Wo_t = (bf16*)(F.ws + WS_WO);
    unsigned char* Wgu_t = (unsigned char*)(F.ws + WS_WGU); unsigned char* Wd_t = (unsigned char*)(F.ws + WS_WD);
    constexpr int I_GU = 32 * 8, I_D = 8 * 32;
    constexpr int I_EXP = NEX * (2 * I_GU + I_D);
    constexpr int I_IN = 32 * 96, I_SQ = 32 * 32, I_KV = 32 * 64;
    constexpr int NITEMS = I_EXP + I_IN + 3 * I_SQ + I_KV;
    for (int it = gw; it < NITEMS; it += NGW) {
        int r = it;
        if (r < I_EXP) {
            const int e = r / (2 * I_GU + I_D); int q = r % (2 * I_GU + I_D);
            if (q < 2 * I_GU) { const int up = q >= I_GU; if (up) q -= I_GU; const int kb = q / 8, nb = q % 8;
                const float* W = (e < NE) ? (up ? wu : wg) + (size_t)e * DM * FF : (up ? wsu : wsg);
                const int n0 = nb * 64, drow0 = (n0 >> 7) * 256 + (up ? 128 : 0) + (n0 & 127);
                p0_tr_item_f8(W, FF, DM, Wgu_t + (size_t)e * 1024 * DM, kb * 64, n0, drow0, scr, f_lane, WPRE);
            } else { q -= 2 * I_GU; const int kb = q / 32, nb = q % 32;
                const float* W = (e < NE) ? wd + (size_t)e * FF * DM : wsd;
                p0_tr_item_f8(W, DM, FF, Wd_t + (size_t)e * DM * FF, kb * 64, nb * 64, nb * 64, scr, f_lane, WPRE); }
            continue; }
        r -= I_EXP;
        if (r < I_IN) { p0_tr_item(w_in, INC, DM, Win_t, (r / 96) * 64, (r % 96) * 64, (r % 96) * 64, scr, f_lane); continue; } r -= I_IN;
        if (r < I_SQ) { p0_tr_item(w_out, DM, DM, Wout_t, (r / 32) * 64, (r % 32) * 64, (r % 32) * 64, scr, f_lane); continue; } r -= I_SQ;
        if (r < I_SQ) { p0_tr_item(wq, DM, DM, Wq_t, (r / 32) * 64, (r % 32) * 64, (r % 32) * 64, scr, f_lane); continue; } r -= I_SQ;
        if (r < I_SQ) { p0_tr_item(wo, DM, DM, Wo_t, (r / 32) * 64, (r % 32) * 64, (r % 32) * 64, scr, f_lane); continue; } r -= I_SQ;
        p0_tr_item(wkv, 2 * DM, DM, Wkv_t, (r / 64) * 64, (r % 64) * 64, (r % 64) * 64, scr, f_lane);
    }
    { const size_t gt = (size_t)(F.vcu * NWAVES * 64) + f_tid, NT = (size_t)F.G * NWAVES * 64;
      bf16* Xb = (bf16*)(F.ws + WS_XB); bf16* Mb = (bf16*)(F.ws + WS_MB);
      for (size_t i = gt; i < (size_t)NTOK * DM / 8; i += NT) { const f32x4 v0 = *(const GAS f32x4*)(x + i * 8), v1 = *(const GAS f32x4*)(x + i * 8 + 4);
          u32x4 o; o.x = pk2(v0.x, v0.y); o.y = pk2(v0.z, v0.w); o.z = pk2(v1.x, v1.y); o.w = pk2(v1.z, v1.w); *(GAS u32x4*)(Xb + i * 8) = o; }
      for (size_t i = gt; i < (size_t)NB * MEML * DM / 8; i += NT) { const f32x4 v0 = *(const GAS f32x4*)(mem + i * 8), v1 = *(const GAS f32x4*)(mem + i * 8 + 4);
          u32x4 o; o.x = pk2(v0.x, v0.y); o.y = pk2(v0.z, v0.w); o.z = pk2(v1.x, v1.y); o.w = pk2(v1.z, v1.w); *(GAS u32x4*)(Mb + i * 8) = o; }
      bf16* Wr = (bf16*)(F.ws + WS_WR);
      for (size_t i = gt; i < (size_t)NE * DM; i += NT) { const int e = (int)(i / DM), k = (int)(i % DM); const float w = wr[(size_t)k * NE + e]; const unsigned h = f2bf(w); const float lo = w - __builtin_bit_cast(float, h << 16);
          Wr[i] = (bf16)h; Wr[(size_t)NE * DM + i] = (bf16)f2bf(lo); } }
}

constexpr int DA_STRIDE = 288, DA_KOFF = 0, DA_VOFF = 256 * DA_STRIDE;
__device__ __forceinline__ void dattn_unit(Frame& F, int uid) {
    const int f_lane = F_LANE(F), f_tid = F.wave * 64 + f_lane; (void)f_tid;
    const bf16* Qp = (const bf16*)(F.ws + WS_PROJ); const bf16* Kp = Qp + (size_t)NTOK * AW; const bf16* Vp = Kp + (size_t)NTOK * AW;
    bf16* og = (bf16*)(F.ws + WS_OG); float* lse = (float*)(F.ws + WS_LSE);
    const int bh = uid / 96, k96 = uid % 96, g = k96 >> 5, rem = k96 & 31, d = 1 << (2 * g), tps = 32 >> (2 * g);
    const int r = rem / tps, n = rem % tps, b = bh >> 3, h = bh & 7;
    const int tid = f_tid, lane = f_lane, w = F.wave, fr = lane & 15, fq = lane >> 4;
    LAS unsigned char* lds = F.lds;
    {
        u32x4 kr[8], vr[8];
#pragma unroll
        for (int p = 0; p < 8; ++p) { const int kb = p * 32 + (tid >> 4), ch = tid & 15, ki = 128 * n - 128 + kb;
            if (ki >= 0) { const size_t off = ((size_t)(b * SEQL + ki * d + r)) * AW + h * HD + ch * 8; kr[p] = *(const GAS u32x4*)(Kp + off); vr[p] = *(const GAS u32x4*)(Vp + off); }
            else { kr[p] = (u32x4){0u, 0u, 0u, 0u}; vr[p] = kr[p]; } }
#pragma unroll
        for (int p = 0; p < 8; ++p) { const int kb = p * 32 + (tid >> 4), ch = tid & 15;
            *(LAS u32x4*)(lds + DA_KOFF + kb * DA_STRIDE + ch * 16) = kr[p]; *(LAS u32x4*)(lds + DA_VOFF + kb * DA_STRIDE + ch * 16) = vr[p]; }
    }
    const int qi = 128 * n + 16 * w + fr; const size_t tq = (size_t)(b * SEQL + qi * d + r);
    bf16x8 qf[4];
#pragma unroll
    for (int ks = 0; ks < 4; ++ks) qf[ks] = *(const GAS bf16x8*)(Qp + tq * AW + h * HD + 32 * ks + 8 * fq);
    __syncthreads();
    const int kstart = 32 * (w >> 1);
    f32x4 S[10];
#pragma unroll
    for (int T = 0; T < 10; ++T) { S[T] = (f32x4){0.f, 0.f, 0.f, 0.f};
#pragma unroll
        for (int ks = 0; ks < 4; ++ks) { const bf16x8 kf = *(const LAS bf16x8*)(lds + DA_KOFF + (kstart + 16 * T + fr) * DA_STRIDE + (32 * ks + 8 * fq) * 2);
            S[T] = __builtin_amdgcn_mfma_f32_16x16x32_bf16(kf, qf[ks], S[T], 0, 0, 0); } }
    const int qb = 128 + 16 * w + fr; float mx = -INFINITY;
#pragma unroll
    for (int T = 0; T < 10; ++T)
#pragma unroll
        for (int j = 0; j < 4; ++j) { const int kb = kstart + 16 * T + 4 * fq + j, dist = qb - kb; const bool ok = dist >= 0 && dist <= 128 && (n > 0 || kb >= 128);
            S[T][j] = ok ? S[T][j] : -INFINITY; mx = fmaxf(mx, S[T][j]); }
    mx = fmaxf(mx, __shfl_xor(mx, 16)); mx = fmaxf(mx, __shfl_xor(mx, 32));
    float sum = 0.f;
#pragma unroll
    for (int T = 0; T < 10; ++T)
#pragma unroll
        for (int j = 0; j < 4; ++j) { const float p = __builtin_amdgcn_exp2f(S[T][j] - mx); S[T][j] = p; sum += p; }
    sum += __shfl_xor(sum, 16); sum += __shfl_xor(sum, 32);
    bf16x8 pf[5];
#pragma unroll
    for (int s = 0; s < 5; ++s) { u32x4 wv; wv.x = pk2(S[2 * s][0], S[2 * s][1]); wv.y = pk2(S[2 * s][2], S[2 * s][3]); wv.z = pk2(S[2 * s + 1][0], S[2 * s + 1][1]); wv.w = pk2(S[2 * s + 1][2], S[2 * s + 1][3]); pf[s] = __builtin_bit_cast(bf16x8, wv); }
    f32x4 O[8];
#pragma unroll
    for (int dt = 0; dt < 8; ++dt) O[dt] = (f32x4){0.f, 0.f, 0.f, 0.f};
    const int q4 = fr >> 2, p4 = fr & 3;
    LAS unsigned char* vbase = lds + DA_VOFF + (kstart + 4 * fq + q4) * DA_STRIDE + p4 * 8;
#pragma unroll
    for (int s = 0; s < 5; ++s)
#pragma unroll
        for (int dt = 0; dt < 8; ++dt) {
            const s16x4 lo = __builtin_amdgcn_ds_read_tr16_b64_v4i16((LAS s16x4*)(vbase + (32 * s) * DA_STRIDE + dt * 32));
            const s16x4 hi = __builtin_amdgcn_ds_read_tr16_b64_v4i16((LAS s16x4*)(vbase + (32 * s + 16) * DA_STRIDE + dt * 32));
            const bf16x8 vf = {lo[0], lo[1], lo[2], lo[3], hi[0], hi[1], hi[2], hi[3]};
            O[dt] = __builtin_amdgcn_mfma_f32_16x16x32_bf16(vf, pf[s], O[dt], 0, 0, 0); }
    const float inv = 1.0f / sum;
    bf16* orow = og + ((size_t)g * NTOK + tq) * AW + h * HD + 4 * fq;
#pragma unroll
    for (int dt = 0; dt < 8; ++dt) { u32x2 o; o.x = pk2(O[dt][0] * inv, O[dt][1] * inv); o.y = pk2(O[dt][2] * inv, O[dt][3] * inv); *(GAS u32x2*)(orow + 16 * dt) = o; }
    if (fq == 0) lse[((size_t)g * NTOK + tq) * NH + h] = mx + __builtin_amdgcn_logf(sum);
    __syncthreads();
}

__device__ __forceinline__ void p3_token(Frame& F, const Args& a, int t) {
    const int f_lane = F_LANE(F), f_tid = F.wave * 64 + f_lane; (void)f_tid;
    const bf16* proj = (const bf16*)(F.ws + WS_PROJ); const bf16* og = (const bf16*)(F.ws + WS_OG); const float* lse = (const float*)(F.ws + WS_LSE);
    bf16* mixed = (bf16*)(F.ws + WS_MIXED);
    const float* conv_w = a.in[3]; const float* g_attn = a.in[4]; const float* g_conv = a.in[5];
    const int lane = f_lane, c0 = lane * 16, h = lane >> 3, s = t % SEQL;
    float l0 = lse[(size_t)t * NH + h], l1 = lse[((size_t)NTOK + t) * NH + h], l2 = lse[((size_t)2 * NTOK + t) * NH + h];
    const float lm = fmaxf(l0, fmaxf(l1, l2)); float w0 = __builtin_amdgcn_exp2f(l0 - lm), w1 = __builtin_amdgcn_exp2f(l1 - lm), w2 = __builtin_amdgcn_exp2f(l2 - lm);
    const float wi = 1.0f / (w0 + w1 + w2); w0 *= wi; w1 *= wi; w2 *= wi;
    float av[16], cv[16];
    {
        const u32x4 a0 = *(const GAS u32x4*)(og + (size_t)t * AW + c0), a1 = *(const GAS u32x4*)(og + (size_t)t * AW + c0 + 8);
        const u32x4 b0 = *(const GAS u32x4*)(og + ((size_t)NTOK + t) * AW + c0), b1 = *(const GAS u32x4*)(og + ((size_t)NTOK + t) * AW + c0 + 8);
        const u32x4 d0 = *(const GAS u32x4*)(og + ((size_t)2 * NTOK + t) * AW + c0), d1 = *(const GAS u32x4*)(og + ((size_t)2 * NTOK + t) * AW + c0 + 8);
#pragma unroll
        for (int i = 0; i < 4; ++i) { av[2 * i] = w0 * bflo(a0[i]) + w1 * bflo(b0[i]) + w2 * bflo(d0[i]); av[2 * i + 1] = w0 * bfhi(a0[i]) + w1 * bfhi(b0[i]) + w2 * bfhi(d0[i]);
            av[8 + 2 * i] = w0 * bflo(a1[i]) + w1 * bflo(b1[i]) + w2 * bflo(d1[i]); av[8 + 2 * i + 1] = w0 * bfhi(a1[i]) + w1 * bfhi(b1[i]) + w2 * bfhi(d1[i]); }
    }
    {
        const bf16* Bg = proj + (size_t)3 * NTOK * AW; const bf16* Cg = proj + (size_t)4 * NTOK * AW; const bf16* Hg = proj + (size_t)5 * NTOK * AW;
#pragma unroll
        for (int i = 0; i < 16; ++i) cv[i] = 0.f;
#pragma unroll
        for (int tap = 0; tap < 3; ++tap) { const int back = 2 - tap;
            if (s - back >= 0) { const size_t off = (size_t)(t - back) * AW + c0;
                const u32x4 cA = *(const GAS u32x4*)(Cg + off), cB = *(const GAS u32x4*)(Cg + off + 8), hA = *(const GAS u32x4*)(Hg + off), hB = *(const GAS u32x4*)(Hg + off + 8);
                const f32x4 wv0 = *(const GAS f32x4*)(conv_w + tap * AW + c0), wv1 = *(const GAS f32x4*)(conv_w + tap * AW + c0 + 4), wv2 = *(const GAS f32x4*)(conv_w + tap * AW + c0 + 8), wv3 = *(const GAS f32x4*)(conv_w + tap * AW + c0 + 12);
                const float wv[16] = {wv0.x, wv0.y, wv0.z, wv0.w, wv1.x, wv1.y, wv1.z, wv1.w, wv2.x, wv2.y, wv2.z, wv2.w, wv3.x, wv3.y, wv3.z, wv3.w};
#pragma unroll
                for (int i = 0; i < 4; ++i) { cv[2 * i] += wv[2 * i] * bflo(cA[i]) * bflo(hA[i]); cv[2 * i + 1] += wv[2 * i + 1] * bfhi(cA[i]) * bfhi(hA[i]);
                    cv[8 + 2 * i] += wv[8 + 2 * i] * bflo(cB[i]) * bflo(hB[i]); cv[8 + 2 * i + 1] += wv[8 + 2 * i + 1] * bfhi(cB[i]) * bfhi(hB[i]); } } }
        const u32x4 bA = *(const GAS u32x4*)(Bg + (size_t)t * AW + c0), bB = *(const GAS u32x4*)(Bg + (size_t)t * AW + c0 + 8);
#pragma unroll
        for (int i = 0; i < 4; ++i) { cv[2 * i] *= bflo(bA[i]); cv[2 * i + 1] *= bfhi(bA[i]); cv[8 + 2 * i] *= bflo(bB[i]); cv[8 + 2 * i + 1] *= bfhi(bB[i]); }
    }
    float sa = 0.f, sc = 0.f;
#pragma unroll
    for (int i = 0; i < 16; ++i) { sa += av[i] * av[i]; sc += cv[i] * cv[i]; }
    sa = wave_sum(sa); sc = wave_sum(sc);
    const float ra = __builtin_amdgcn_rsqf(sa * (1.0f / 1024.f) + RMS_EPS), rc = __builtin_amdgcn_rsqf(sc * (1.0f / 1024.f) + RMS_EPS);
    u32x4 oa0, oa1, oc0, oc1;
    {
        const f32x4 g0 = *(const GAS f32x4*)(g_attn + c0), g1 = *(const GAS f32x4*)(g_attn + c0 + 4), g2 = *(const GAS f32x4*)(g_attn + c0 + 8), g3 = *(const GAS f32x4*)(g_attn + c0 + 12);
        oa0.x = pk2(av[0] * ra * g0.x, av[1] * ra * g0.y); oa0.y = pk2(av[2] * ra * g0.z, av[3] * ra * g0.w); oa0.z = pk2(av[4] * ra * g1.x, av[5] * ra * g1.y); oa0.w = pk2(av[6] * ra * g1.z, av[7] * ra * g1.w);
        oa1.x = pk2(av[8] * ra * g2.x, av[9] * ra * g2.y); oa1.y = pk2(av[10] * ra * g2.z, av[11] * ra * g2.w); oa1.z = pk2(av[12] * ra * g3.x, av[13] * ra * g3.y); oa1.w = pk2(av[14] * ra * g3.z, av[15] * ra * g3.w);
        const f32x4 k0 = *(const GAS f32x4*)(g_conv + c0), k1 = *(const GAS f32x4*)(g_conv + c0 + 4), k2 = *(const GAS f32x4*)(g_conv + c0 + 8), k3 = *(const GAS f32x4*)(g_conv + c0 + 12);
        oc0.x = pk2(cv[0] * rc * k0.x, cv[1] * rc * k0.y); oc0.y = pk2(cv[2] * rc * k0.z, cv[3] * rc * k0.w); oc0.z = pk2(cv[4] * rc * k1.x, cv[5] * rc * k1.y); oc0.w = pk2(cv[6] * rc * k1.z, cv[7] * rc * k1.w);
        oc1.x = pk2(cv[8] * rc * k2.x, cv[9] * rc * k2.y); oc1.y = pk2(cv[10] * rc * k2.z, cv[11] * rc * k2.w); oc1.z = pk2(cv[12] * rc * k3.x, cv[13] * rc * k3.y); oc1.w = pk2(cv[14] * rc * k3.z, cv[15] * rc * k3.w);
    }
    bf16* mrow = mixed + (size_t)t * DM + c0;
    *(GAS u32x4*)(mrow) = oa0; *(GAS u32x4*)(mrow + 8) = oa1; *(GAS u32x4*)(mrow + AW) = oc0; *(GAS u32x4*)(mrow + AW + 8) = oc1;
}

__device__ __forceinline__ void ln_row(const float* in, const float* g, const float* bta, float* outf, bf16* outb, unsigned char* outq, int lane) {
    const GAS f32x4* xr = (const GAS f32x4*)in + lane;
    f32x4 v[8]; float s = 0.f;
#pragma unroll
    for (int j = 0; j < 8; ++j) { v[j] = xr[64 * j]; s += (v[j].x + v[j].y) + (v[j].z + v[j].w); }
    const float mean = wave_sum(s) * (1.f / DM); float s2 = 0.f;
#pragma unroll
    for (int j = 0; j < 8; ++j) { v[j] = v[j] - mean; s2 += (v[j].x * v[j].x + v[j].y * v[j].y) + (v[j].z * v[j].z + v[j].w * v[j].w); }
    const float rstd = __builtin_amdgcn_rsqf(wave_sum(s2) * (1.f / DM) + LN_EPS);
#pragma unroll
    for (int j = 0; j < 8; ++j) { const f32x4 gg = *((const GAS f32x4*)g + lane + 64 * j), bb = *((const GAS f32x4*)bta + lane + 64 * j);
        const f32x4 o = v[j] * rstd * gg + bb;
        *((GAS f32x4*)outf + lane + 64 * j) = o;
        if (outb) { u32x2 w; w.x = pk2(o.x, o.y); w.y = pk2(o.z, o.w); *((GAS u32x2*)outb + lane + 64 * j) = w; }
        if (outq) *((GAS unsigned*)outq + lane + 64 * j) = pg8::pk4_fp8(o.x, o.y, o.z, o.w); }
}

constexpr int XA_STRIDE = 144, XA_BUF = 256 * XA_STRIDE;
__device__ __forceinline__ void xattn_unit(Frame& F, int uid) {
    const int f_lane = F_LANE(F), f_tid = F.wave * 64 + f_lane; (void)f_tid;
    const bf16* Qm = (const bf16*)(F.ws + WS_QM); const bf16* KVm = (const bf16*)(F.ws + WS_KVM); bf16* Om = (bf16*)(F.ws + WS_OM);
    const int qt = uid >> 2, hh = uid & 3, b = (qt * 128) / SEQL;
    const int tid = f_tid, lane = f_lane, w = F.wave, fr = lane & 15, fq = lane >> 4;
    LAS unsigned char* lds = F.lds;
    const size_t tq = (size_t)qt * 128 + 16 * w + fr;
    const bf16* kvb = KVm + (size_t)(b * MEML) * (2 * DM) + hh * MHD;
#define XA_LOAD(cc, regs) do { const int _col = ((cc) < 8 ? (cc) * 64 : DM + ((cc) - 8) * 64); _Pragma("unroll") for (int _p = 0; _p < 4; ++_p) { const int _row = _p * 64 + (tid >> 3), _ch = tid & 7; \
        regs[_p] = *(const GAS u32x4*)(kvb + (size_t)_row * (2 * DM) + _col + _ch * 8); } } while (0)
#define XA_WRITE(buf, regs) do { _Pragma("unroll") for (int _p = 0; _p < 4; ++_p) { const int _row = _p * 64 + (tid >> 3), _ch = tid & 7; *(LAS u32x4*)(lds + (buf) * XA_BUF + _row * XA_STRIDE + _ch * 16) = regs[_p]; } } while (0)
    u32x4 st[4];
    XA_LOAD(0, st); XA_WRITE(0, st);
    __syncthreads();
    f32x4 S[16];
#pragma unroll
    for (int T = 0; T < 16; ++T) S[T] = (f32x4){0.f, 0.f, 0.f, 0.f};
#pragma unroll 1
    for (int c = 0; c < 8; ++c) {
        XA_LOAD(c + 1, st);
        const bf16x8 q0 = *(const GAS bf16x8*)(Qm + tq * DM + hh * MHD + c * 64 + 8 * fq), q1 = *(const GAS bf16x8*)(Qm + tq * DM + hh * MHD + c * 64 + 32 + 8 * fq);
        LAS unsigned char* kb = lds + (c & 1) * XA_BUF + fr * XA_STRIDE + fq * 16;
#pragma unroll
        for (int T = 0; T < 16; ++T) { const bf16x8 k0 = *(const LAS bf16x8*)(kb + 16 * T * XA_STRIDE), k1 = *(const LAS bf16x8*)(kb + 16 * T * XA_STRIDE + 64);
            S[T] = __builtin_amdgcn_mfma_f32_16x16x32_bf16(k0, q0, S[T], 0, 0, 0); S[T] = __builtin_amdgcn_mfma_f32_16x16x32_bf16(k1, q1, S[T], 0, 0, 0); }
        XA_WRITE((c + 1) & 1, st);
        __syncthreads();
    }
    float mx = -INFINITY;
#pragma unroll
    for (int T = 0; T < 16; ++T)
#pragma unroll
        for (int j = 0; j < 4; ++j) mx = fmaxf(mx, S[T][j]);
    mx = fmaxf(mx, __shfl_xor(mx, 16)); mx = fmaxf(mx, __shfl_xor(mx, 32));
    float sum = 0.f;
#pragma unroll
    for (int T = 0; T < 16; ++T)
#pragma unroll
        for (int j = 0; j < 4; ++j) { const float p = __builtin_amdgcn_exp2f(S[T][j] - mx); S[T][j] = p; sum += p; }
    sum += __shfl_xor(sum, 16); sum += __shfl_xor(sum, 32);
    const float inv = 1.0f / sum;
    bf16x8 pf[8];
#pragma unroll
    for (int s = 0; s < 8; ++s) { u32x4 wv; wv.x = pk2(S[2 * s][0] * inv, S[2 * s][1] * inv); wv.y = pk2(S[2 * s][2] * inv, S[2 * s][3] * inv); wv.z = pk2(S[2 * s + 1][0] * inv, S[2 * s + 1][1] * inv); wv.w = pk2(S[2 * s + 1][2] * inv, S[2 * s + 1][3] * inv); pf[s] = __builtin_bit_cast(bf16x8, wv); }
    const int q4 = fr >> 2, p4 = fr & 3;
#pragma unroll 1
    for (int c = 8; c < 16; ++c) {
        if (c + 1 < 16) XA_LOAD(c + 1, st);
        LAS unsigned char* vb = lds + (c & 1) * XA_BUF + (4 * fq + q4) * XA_STRIDE + p4 * 8;
        f32x4 O[4];
#pragma unroll
        for (int dt = 0; dt < 4; ++dt) O[dt] = (f32x4){0.f, 0.f, 0.f, 0.f};
#pragma unroll
        for (int s = 0; s < 8; ++s)
#pragma unroll
            for (int dt = 0; dt < 4; ++dt) {
                const s16x4 lo = __builtin_amdgcn_ds_read_tr16_b64_v4i16((LAS s16x4*)(vb + (32 * s) * XA_STRIDE + dt * 32));
                const s16x4 hi = __builtin_amdgcn_ds_read_tr16_b64_v4i16((LAS s16x4*)(vb + (32 * s + 16) * XA_STRIDE + dt * 32));
                const bf16x8 vf = {lo[0], lo[1], lo[2], lo[3], hi[0], hi[1], hi[2], hi[3]};
                O[dt] = __builtin_amdgcn_mfma_f32_16x16x32_bf16(vf, pf[s], O[dt], 0, 0, 0); }
        bf16* orow = Om + tq * DM + hh * MHD + (c - 8) * 64 + 4 * fq;
#pragma unroll
        for (int dt = 0; dt < 4; ++dt) { u32x2 o; o.x = pk2(O[dt][0], O[dt][1]); o.y = pk2(O[dt][2], O[dt][3]); *(GAS u32x2*)(orow + 16 * dt) = o; }
        if (c + 1 < 16) XA_WRITE((c + 1) & 1, st);
        __syncthreads();
    }
#undef XA_LOAD
#undef XA_WRITE
}

__device__ __forceinline__ void route_wg(Frame& F, const Args& a, int wt) {
    const int f_lane = F_LANE(F), f_tid = F.wave * 64 + f_lane; (void)f_tid;
    const float* x2 = (const float*)(F.ws + WS_X1); const bf16* Wr = (const bf16*)(F.ws + WS_WR); const float* rbias = a.in[15];
    float* gates = (float*)(F.ws + WS_GATES); int* ltok = (int*)(F.ws + WS_LTOK); int* lslot = (int*)(F.ws + WS_LSLOT);
    const int lane = f_lane, fr = lane & 15, fq = lane >> 4, w = F.wave, t0 = wt * 64 + 16 * (w & 3), kh = w >> 2;
    LAS float* part = (LAS float*)(F.lds);
    LAS unsigned* lc = (LAS unsigned*)(F.lds + 16384);
    if (f_tid < 128) lc[f_tid] = 0u;
    f32x4 acc[4];
#pragma unroll
    for (int T = 0; T < 4; ++T) acc[T] = (f32x4){0.f, 0.f, 0.f, 0.f};
    const float* xrow = x2 + (size_t)(t0 + fr) * DM + kh * 1024 + 8 * fq;
    const bf16* wbase = Wr + (size_t)fr * DM + kh * 1024 + 8 * fq;
#pragma unroll 4
    for (int ks = 0; ks < 32; ++ks) {
        const f32x4 xa = *(const GAS f32x4*)(xrow + 32 * ks), xb = *(const GAS f32x4*)(xrow + 32 * ks + 4);
        const float xv[8] = {xa.x, xa.y, xa.z, xa.w, xb.x, xb.y, xb.z, xb.w};
        u32x4 hw, lw;
#pragma unroll
        for (int i = 0; i < 4; ++i) { const unsigned h0 = f2bf(xv[2 * i]), h1 = f2bf(xv[2 * i + 1]); hw[i] = h0 | (h1 << 16);
            lw[i] = pk2(xv[2 * i] - __builtin_bit_cast(float, h0 << 16), xv[2 * i + 1] - __builtin_bit_cast(float, h1 << 16)); }
        const bf16x8 xh = __builtin_bit_cast(bf16x8, hw), xl = __builtin_bit_cast(bf16x8, lw);
#pragma unroll
        for (int T = 0; T < 4; ++T) { const bf16* wp = wbase + (size_t)(16 * T) * DM + 32 * ks;
            const bf16x8 wh = *(const GAS bf16x8*)wp, wl = *(const GAS bf16x8*)(wp + (size_t)NE * DM);
            acc[T] = __builtin_amdgcn_mfma_f32_16x16x32_bf16(wh, xh, acc[T], 0, 0, 0);
            acc[T] = __builtin_amdgcn_mfma_f32_16x16x32_bf16(wh, xl, acc[T], 0, 0, 0);
            acc[T] = __builtin_amdgcn_mfma_f32_16x16x32_bf16(wl, xh, acc[T], 0, 0, 0); }
    }
    if (kh == 1) {
#pragma unroll
        for (int T = 0; T < 4; ++T) *(LAS f32x4*)(part + (((w & 3) * 4 + T) * 64 + lane) * 4) = acc[T];
    }
    __syncthreads();
    int myidx[2] = {0, 0}; float mygate[2] = {0.f, 0.f}; unsigned mypos[2] = {0u, 0u};
    if (kh == 0) {
        float sc[4][4], ch[4][4];
#pragma unroll
        for (int T = 0; T < 4; ++T) { const f32x4 p = *(const LAS f32x4*)(part + ((w * 4 + T) * 64 + lane) * 4); const f32x4 bv = *(const GAS f32x4*)(rbias + 16 * T + 4 * fq);
#pragma unroll
            for (int j = 0; j < 4; ++j) { const float z = acc[T][j] + p[j]; sc[T][j] = __builtin_amdgcn_rcpf(1.0f + __builtin_amdgcn_exp2f(-1.44269504f * z)); ch[T][j] = sc[T][j] + bv[j]; } }
        float gsc[8];
#pragma unroll
        for (int T = 0; T < 4; ++T) {
            float a1 = fmaxf(ch[T][0], ch[T][1]), a2 = fminf(ch[T][0], ch[T][1]); const float c1 = fmaxf(ch[T][2], ch[T][3]), c2 = fminf(ch[T][2], ch[T][3]);
            float m1 = fmaxf(a1, c1), m2 = fmaxf(fminf(a1, c1), fmaxf(a2, c2));
            const float b1 = __shfl_xor(m1, 16), b2 = __shfl_xor(m2, 16);
            const float g1 = fmaxf(m1, b1), g2 = fmaxf(fminf(m1, b1), fmaxf(m2, b2)); const float gs = g1 + g2;
            const float og = __shfl_xor(gs, 32);
            gsc[2 * T] = (fq >> 1) ? og : gs; gsc[2 * T + 1] = (fq >> 1) ? gs : og;
        }
        unsigned gsel = 0u;
#pragma unroll
        for (int i = 0; i < 8; ++i) { int rank = 0;
#pragma unroll
            for (int j = 0; j < 8; ++j) rank += (gsc[j] > gsc[i] || (gsc[j] == gsc[i] && j < i)) ? 1 : 0;
            gsel |= (rank < 4 ? 1u : 0u) << i; }
        float cv[16]; float sv[16];
#pragma unroll
        for (int T = 0; T < 4; ++T)
#pragma unroll
            for (int j = 0; j < 4; ++j) { cv[T * 4 + j] = ((gsel >> (2 * T + (fq >> 1))) & 1u) ? ch[T][j] : -INFINITY; sv[T * 4 + j] = sc[T][j]; }
        float wsum = 0.f; float selsc[8]; int selid[8];
#pragma unroll
        for (int r = 0; r < 8; ++r) {
            float bv = -INFINITY, bs = 0.f; int bi = 64;
#pragma unroll
            for (int q = 0; q < 16; ++q) { const int e = 16 * (q >> 2) + 4 * fq + (q & 3); const bool better = cv[q] > bv; bv = better ? cv[q] : bv; bs = better ? sv[q] : bs; bi = better ? e : bi; }
#pragma unroll
            for (int o = 16; o <= 32; o <<= 1) { const float ov = __shfl_xor(bv, o), os = __shfl_xor(bs, o); const int oi = __shfl_xor(bi, o);
                const bool take = ov > bv || (ov == bv && oi < bi); bv = take ? ov : bv; bs = take ? os : bs; bi = take ? oi : bi; }
#pragma unroll
            for (int q = 0; q < 16; ++q) { const int e = 16 * (q >> 2) + 4 * fq + (q & 3); cv[q] = (e == bi) ? -INFINITY : cv[q]; }
            selsc[r] = bs; selid[r] = bi; wsum += bs;
        }
        const float wn = 2.5f / wsum;
#pragma unroll
        for (int r = 0; r < 8; ++r) if ((r >> 1) == fq) { myidx[r & 1] = selid[r]; mygate[r & 1] = selsc[r] * wn; }
#pragma unroll
        for (int i = 0; i < 2; ++i) mypos[i] = __hip_atomic_fetch_add(lc + myidx[i], 1u, __ATOMIC_RELAXED, __HIP_MEMORY_SCOPE_WORKGROUP);
    }
    __syncthreads();
    if (f_tid < NE) { const unsigned n = lc[f_tid]; unsigned base = 0u; if (n) base = __hip_atomic_fetch_add((unsigned*)(F.ctl + CW_CNT + 64 * f_tid), n, RLX_AGENT); lc[64 + f_tid] = base; }
    __syncthreads();
    if (kh == 0) {
        const int t = t0 + fr;
#pragma unroll
        for (int i = 0; i < 2; ++i) { const int e = myidx[i], r = 2 * fq + i; const int pos = (int)(lc[64 + e] + mypos[i]);
            ltok[e * CAP + pos] = t; lslot[e * CAP + pos] = t * 8 + r; gates[t * 8 + r] = mygate[i]; }
    }
    __syncthreads();
}

struct GroupOrder {
    volatile LAS unsigned* MISC; const char* Abase; const char* Bbase; size_t Bstride; int K; int nmine; bool gather;
    __device__ __forceinline__ bool next(int i, pg8::Unit& u) const {
        if (i >= nmine) return false;
        const int pk = __builtin_amdgcn_readfirstlane((int)MISC[MW_UL + i]);
        const int e = pk >> 16, rt = (pk >> 4) & 0xfff, pn = pk & 15;
        u.pm = rt; u.pn = pn; u.e = e; u.slot = i;
        u.B = Bbase + (size_t)e * Bstride + (size_t)pn * 256 * K * 2;
        const int rb = __builtin_amdgcn_readfirstlane((int)MISC[MW_RB + e]);
        u.A = gather ? Abase : Abase + ((size_t)rb + (size_t)rt * 256) * K * 2;
        return true;
    }
};
__device__ __forceinline__ int group_setup(Frame& F, int npn, const int* list, int padfill) {
    const int f_lane = F_LANE(F), f_tid = F.wave * 64 + f_lane; (void)f_tid;
    volatile LAS unsigned* M = F.MISC; LAS int* tab = (LAS int*)(F.lds + TAB_OFF);
    __syncthreads();
    if (f_tid < NEX) { const int c = (f_tid < NE) ? (int)__hip_atomic_load(F.ctl + CW_CNT + 64 * f_tid, RLX_AGENT) : NTOK; M[MW_CNT + f_tid] = (unsigned)c; }
    __syncthreads();
    if (f_tid == 0) { unsigned up = 0, rb = 0; for (int e = 0; e < NEX; ++e) { const unsigned nt = (M[MW_CNT + e] + 255u) >> 8; M[MW_PRE + e] = up; M[MW_RB + e] = rb; up += nt * (unsigned)npn; rb += nt * 256u; } M[MW_PRE + NEX] = up; }
    __syncthreads();
    const int nun = (int)M[MW_PRE + NEX];
    if (f_tid < MAXU) {
        const long L = (long)f_tid * F.G + (int)blockIdx.x; unsigned pk = 0xffffffffu;
        if (L < nun) { int wgid = (int)L; { const int q = nun / 8, r = nun % 8, xcd = wgid % 8, off = wgid / 8; wgid = (xcd < r ? xcd * (q + 1) : r * (q + 1) + (xcd - r) * q) + off; }
            int e = 0; for (int s = 64; s >= 1; s >>= 1) { if (e + s < NEX && (int)M[MW_PRE + e + s] <= wgid) e += s; }
            const int j = wgid - (int)M[MW_PRE + e]; pk = ((unsigned)e << 16) | ((unsigned)(j / npn) << 4) | (unsigned)(j % npn); }
        M[MW_UL + f_tid] = pk;
    }
    __syncthreads();
    int nm = 0; for (int i = 0; i < MAXU; ++i) if (M[MW_UL + i] != 0xffffffffu) nm = i + 1;
    for (int i = 0; i < nm; ++i) { const unsigned pk = M[MW_UL + i]; const int e = (int)(pk >> 16), rt = (int)((pk >> 4) & 0xfff), cnt = (int)M[MW_CNT + e];
        if (f_tid < 256) { const int r = rt * 256 + f_tid; int v = padfill; if (r < cnt) v = (e < NE) ? list[(size_t)e * CAP + r] : r; tab[i * 256 + f_tid] = v; } }
    __syncthreads();
    return nm;
}

__device__ __forceinline__ void final_row(Frame& F, const Args& a, int t) {
    const int f_lane = F_LANE(F), f_tid = F.wave * 64 + f_lane; (void)f_tid;
    const float* X2 = (const float*)(F.ws + WS_X1);
    const bf16* Y = (const bf16*)(F.ws + WS_Y); const float* gates = (const float*)(F.ws + WS_GATES);
    const float* g = a.in[22]; const float* bta = a.in[23]; float* out = a.out + (size_t)t * DM;
    const int lane = f_lane;
    float v[4][8];
#pragma unroll
    for (int j = 0; j < 4; ++j) { const f32x4 p0 = *(const GAS f32x4*)(X2 + (size_t)t * DM + 512 * j + 8 * lane), p1 = *(const GAS f32x4*)(X2 + (size_t)t * DM + 512 * j + 8 * lane + 4);
        v[j][0] = p0.x; v[j][1] = p0.y; v[j][2] = p0.z; v[j][3] = p0.w; v[j][4] = p1.x; v[j][5] = p1.y; v[j][6] = p1.z; v[j][7] = p1.w; }
    const f32x4 gk0 = *(const GAS f32x4*)(gates + t * 8), gk1 = *(const GAS f32x4*)(gates + t * 8 + 4);
    const float gk[8] = {gk0.x, gk0.y, gk0.z, gk0.w, gk1.x, gk1.y, gk1.z, gk1.w};
#pragma unroll
    for (int k = 0; k < 8; ++k) { const bf16* yr = Y + (size_t)(t * 8 + k) * DM + 8 * lane;
#pragma unroll
        for (int j = 0; j < 4; ++j) { const u32x4 w = __builtin_nontemporal_load((const GAS u32x4*)(yr + 512 * j));
#pragma unroll
            for (int i = 0; i < 4; ++i) { v[j][2 * i] += gk[k] * bflo(w[i]); v[j][2 * i + 1] += gk[k] * bfhi(w[i]); } } }
    float s = 0.f;
#pragma unroll
    for (int j = 0; j < 4; ++j)
#pragma unroll
        for (int i = 0; i < 8; ++i) s += v[j][i];
    const float mean = wave_sum(s) * (1.f / DM); float s2 = 0.f;
#pragma unroll
    for (int j = 0; j < 4; ++j)
#pragma unroll
        for (int i = 0; i < 8; ++i) { v[j][i] -= mean; s2 += v[j][i] * v[j][i]; }
    const float rstd = __builtin_amdgcn_rsqf(wave_sum(s2) * (1.f / DM) + LN_EPS);
#pragma unroll
    for (int j = 0; j < 4; ++j) { const int c = 512 * j + 8 * lane;
        const f32x4 g0 = *(const GAS f32x4*)(g + c), g1 = *(const GAS f32x4*)(g + c + 4), b0 = *(const GAS f32x4*)(bta + c), b1 = *(const GAS f32x4*)(bta + c + 4);
        f32x4 o0, o1; o0.x = v[j][0] * rstd * g0.x + b0.x; o0.y = v[j][1] * rstd * g0.y + b0.y; o0.z = v[j][2] * rstd * g0.z + b0.z; o0.w = v[j][3] * rstd * g0.w + b0.w;
        o1.x = v[j][4] * rstd * g1.x + b1.x; o1.y = v[j][5] * rstd * g1.y + b1.y; o1.z = v[j][6] * rstd * g1.z + b1.z; o1.w = v[j][7] * rstd * g1.w + b1.w;
        __builtin_nontemporal_store(o0, (GAS f32x4*)(out + c)); __builtin_nontemporal_store(o1, (GAS f32x4*)(out + c + 4)); }
}

__device__ __forceinline__ void ph_inproj(Frame& F, LAS const int* tab) {
    { pg8::DenseOrder S; S.init(F.ws + WS_XB, F.ws + WS_WIN, NTOK, INC, DM, F.G, (int)blockIdx.x);
      pg8::EpiBf16 E{(bf16*)(F.ws + WS_PROJ), AW, AW, (size_t)NTOK * AW, QSCALE};
      pg8::gemm_phase<pg8::EpiBf16, pg8::DenseOrder, false>(F.lds + RING_OFF, DM, S, E, tab, F.wave); }
    { pg8::DenseOrder S; S.init(F.ws + WS_MB, F.ws + WS_WKV, NB * MEML, 2 * DM, DM, F.G, (int)blockIdx.x);
      pg8::EpiBf16 E{(bf16*)(F.ws + WS_KVM), 2 * DM, 0, 0, 1.0f};
      pg8::gemm_phase<pg8::EpiBf16, pg8::DenseOrder, false>(F.lds + RING_OFF, DM, S, E, tab, F.wave); }
}
__device__ __forceinline__ void ph_resproj(Frame& F, LAS const int* tab, size_t a_off, size_t w_off, const float* resid) {
    pg8::DenseOrder S; S.init(F.ws + a_off, F.ws + w_off, NTOK, DM, DM, F.G, (int)blockIdx.x);
    pg8::EpiResF32 E{(float*)(F.ws + WS_T), resid, DM, ALPHA};
    pg8::gemm_phase<pg8::EpiResF32, pg8::DenseOrder, false>(F.lds + RING_OFF, DM, S, E, tab, F.wave);
}
__device__ __forceinline__ void ph_qproj(Frame& F, LAS const int* tab) {
    pg8::DenseOrder S; S.init(F.ws + WS_X1B, F.ws + WS_WQ, NTOK, DM, DM, F.G, (int)blockIdx.x);
    pg8::EpiBf16 E{(bf16*)(F.ws + WS_QM), DM, 0, 0, MQSCALE};
    pg8::gemm_phase<pg8::EpiBf16, pg8::DenseOrder, false>(F.lds + RING_OFF, DM, S, E, tab, F.wave);
}
__device__ __forceinline__ void ph_moe1(Frame& F, LAS const int* tab) {
    GroupOrder S; S.MISC = F.MISC; S.Abase = (const char*)(F.ws + WS_X1B); S.Bbase = (const char*)(F.ws + WS_WGU); S.Bstride = (size_t)1024 * DM; S.K = DM / 2; S.gather = true;
    S.nmine = group_setup(F, 4, (const int*)(F.ws + WS_LTOK), 0);
    pg8::EpiSwiGLU E{(unsigned char*)(F.ws + WS_H), (LAS const int*)(F.lds + MISC_OFF + 4 * MW_RB), WPOST};
    pg8::gemm_phase<pg8::EpiSwiGLU, GroupOrder, true, true>(F.lds + RING_OFF, DM / 2, S, E, tab, F.wave);
}
__device__ __forceinline__ void ph_moe2(Frame& F, LAS const int* tab, int dry) {
    GroupOrder S; S.MISC = F.MISC; S.Abase = (const char*)(F.ws + WS_H); S.Bbase = (const char*)(F.ws + WS_WD); S.Bstride = (size_t)DM * FF; S.K = FF / 2; S.gather = false;
    S.nmine = group_setup(F, 8, (const int*)(F.ws + WS_LSLOT), -1);
    pg8::EpiDown E{(bf16*)(F.ws + WS_Y), (float*)(F.ws + WS_X1), ALPHA, NE, dry, WPOST};
    pg8::gemm_phase<pg8::EpiDown, GroupOrder, false, true>(F.lds + RING_OFF, FF / 2, S, E, tab, F.wave);
}

enum { PH_PRO = 0, PH_INPROJ, PH_DATTN, PH_MIX, PH_OUTPROJ, PH_LN1, PH_QPROJ, PH_XATTN, PH_OPROJ, PH_LN2, PH_ROUTE, PH_MOE1, PH_MOE2, PH_FINAL, PH_END };
__global__ void __launch_bounds__(NWAVES * 64, 2) mk_fwd(Args args) {
    extern __shared__ __attribute__((aligned(16))) unsigned char lds_raw[];
    Frame F;
    F.lds = (LAS unsigned char*)lds_raw; F.MISC = (volatile LAS unsigned*)(F.lds + MISC_OFF);
    F.wave = __builtin_amdgcn_readfirstlane((int)threadIdx.x >> 6);
    F.G = gridDim.x; { const int bx = blockIdx.x; F.vcu = (F.G % 8 == 0) ? (bx % 8) * (F.G / 8) + bx / 8 : bx; }
    F.ws = args.ws; F.ctl = (gu32*)(args.ws + WS_CTL);
    for (int u = (int)threadIdx.x; u < MISC_BYTES / 4; u += NWAVES * 64) F.MISC[u] = 0u;
    __syncthreads();
    XcdBarrier bar; bar.bar = (unsigned*)(F.ctl + CW_BAR); bar.x = 0; bar.st = nullptr; bar.wave = F.wave;
    if (args.use_bar) bar = xcd_barrier_post((unsigned*)(F.ctl + CW_BAR), F.MISC, F.wave);
    const int lo = args.ph_lo, hi = args.ph_hi;
#define IN(k) (lo <= (k) && (k) < hi)
#define SEAM(k) do { if (IN(k) && IN((k) + 1)) xcd_barrier(bar); } while (0)
#ifndef REP_MASK
#define REP_MASK 0
#endif
#define REPS(k) for (int _r = 0; _r <= ((REP_MASK >> (k)) & 1); ++_r)
#define REPBAR(k) do { if (_r < ((REP_MASK >> (k)) & 1)) xcd_barrier(bar); } while (0)
    const int gw = F.vcu * NWAVES + F.wave, NGW = F.G * NWAVES;
    LAS const int* tab = (LAS const int*)(F.lds + TAB_OFF);

    if (IN(PH_PRO)) { REPS(PH_PRO) { p0_prologue(F, args); REPBAR(PH_PRO); } SEAM(PH_PRO); }

    if (IN(PH_INPROJ)) { ph_inproj(F, tab);
#if (REP_MASK >> 1) & 1
        xcd_barrier(bar); ph_inproj(F, tab);
#endif
        SEAM(PH_INPROJ); }
    if (IN(PH_DATTN)) { REPS(PH_DATTN) { for (int u = F.vcu; u < NB * NH * 96; u += F.G) dattn_unit(F, u); REPBAR(PH_DATTN); } SEAM(PH_DATTN); }
    if (IN(PH_MIX)) { REPS(PH_MIX) { for (int t = gw; t < NTOK; t += NGW) p3_token(F, args, t); REPBAR(PH_MIX); } SEAM(PH_MIX); }
    if (IN(PH_OUTPROJ)) { ph_resproj(F, tab, WS_MIXED, WS_WOUT, args.in[0]);
#if (REP_MASK >> 4) & 1
        xcd_barrier(bar); ph_resproj(F, tab, WS_MIXED, WS_WOUT, args.in[0]);
#endif
        SEAM(PH_OUTPROJ); }
    if (IN(PH_LN1)) { REPS(PH_LN1) { for (int t = gw; t < NTOK; t += NGW) ln_row((const float*)(F.ws + WS_T) + (size_t)t * DM, args.in[7], args.in[8], (float*)(F.ws + WS_X1) + (size_t)t * DM, (bf16*)(F.ws + WS_X1B) + (size_t)t * DM, nullptr, F_LANE(F)); REPBAR(PH_LN1); } SEAM(PH_LN1); }
    if (IN(PH_QPROJ)) { ph_qproj(F, tab);
#if (REP_MASK >> 6) & 1
        xcd_barrier(bar); ph_qproj(F, tab);
#endif
        SEAM(PH_QPROJ); }
    if (IN(PH_XATTN)) { REPS(PH_XATTN) { for (int u = F.vcu; u < (NTOK / 128) * NMH; u += F.G) xattn_unit(F, u); REPBAR(PH_XATTN); } SEAM(PH_XATTN); }
    if (IN(PH_OPROJ)) { ph_resproj(F, tab, WS_OM, WS_WO, (const float*)(F.ws + WS_X1));
#if (REP_MASK >> 8) & 1
        xcd_barrier(bar); ph_resproj(F, tab, WS_OM, WS_WO, (const float*)(F.ws + WS_X1));
#endif
        SEAM(PH_OPROJ); }
    if (IN(PH_LN2)) { REPS(PH_LN2) { for (int t = gw; t < NTOK; t += NGW) ln_row((const float*)(F.ws + WS_T) + (size_t)t * DM, args.in[12], args.in[13], (float*)(F.ws + WS_X1) + (size_t)t * DM, nullptr, (unsigned char*)(F.ws + WS_X1B) + (size_t)t * DM, F_LANE(F)); REPBAR(PH_LN2); } SEAM(PH_LN2); }
    if (IN(PH_ROUTE)) {
#if (REP_MASK >> 10) & 1
        for (int wt = F.vcu; wt < NTOK / 64; wt += F.G) route_wg(F, args, wt);
        xcd_barrier(bar); if (blockIdx.x == 0 && (int)threadIdx.x < NE) __hip_atomic_store(F.ctl + CW_CNT + 64 * (int)threadIdx.x, 0u, RLX_AGENT); xcd_barrier(bar);
#endif
        for (int wt = F.vcu; wt < NTOK / 64; wt += F.G) route_wg(F, args, wt); SEAM(PH_ROUTE); }
    if (IN(PH_MOE1)) { ph_moe1(F, tab);
#if (REP_MASK >> 11) & 1
        xcd_barrier(bar); ph_moe1(F, tab);
#endif
        SEAM(PH_MOE1); }
    if (IN(PH_MOE2)) {
#if (REP_MASK >> 12) & 1
        ph_moe2(F, tab, 1); xcd_barrier(bar);
#endif
        ph_moe2(F, tab, 0); SEAM(PH_MOE2); }
    if (IN(PH_FINAL)) { REPS(PH_FINAL) { for (int t = gw; t < NTOK; t += NGW) final_row(F, args, t); REPBAR(PH_FINAL); } }
#undef IN
#undef SEAM
}

static int g_grid = 0;
inline bool mk_init() {
    if (g_grid == 0) {
        int dev = 0, cus = 0;
        if (hipGetDevice(&dev) != hipSuccess || hipDeviceGetAttribute(&cus, hipDeviceAttributeMultiprocessorCount, dev) != hipSuccess) { g_grid = -1; return false; }
        if (hipFuncSetAttribute((const void*)mk_fwd, hipFuncAttributeMaxDynamicSharedMemorySize, LDS_BYTES) != hipSuccess) { g_grid = -1; return false; }
        (void)hipGetLastError();
        g_grid = cus;
    }
    return g_grid > 0;
}
inline void mk_run(void* const* d_in, void* d_out, void* d_ws, hipStream_t stream, int lo, int hi, bool per_phase) {
    if (!mk_init()) return;
    Args a{};
    for (int i = 0; i < 24; ++i) a.in[i] = (const float*)d_in[i];
    a.out = (float*)d_out; a.ws = (unsigned char*)d_ws;
    if (per_phase) { for (int p = lo; p < hi; ++p) { a.ph_lo = p; a.ph_hi = p + 1; a.use_bar = 0; hipLaunchKernelGGL(mk_fwd, dim3(g_grid), dim3(NWAVES * 64), LDS_BYTES, stream, a); } }
    else { a.ph_lo = lo; a.ph_hi = hi; a.use_bar = 1; hipLaunchKernelGGL(mk_fwd, dim3(g_grid), dim3(NWAVES * 64), LDS_BYTES, stream, a); }
}
}
extern "C" void kernel_launch(void* const* d_in, const int* in_sizes, int n_in, void* d_out, int out_size, void* d_ws, size_t ws_size, hipStream_t stream) {
    (void)in_sizes; (void)n_in; (void)out_size; (void)ws_size;
    (void)hipMemsetAsync((char*)d_ws + mk::WS_CTL, 0, mk::CTL_ZERO_BYTES, stream);
    mk::mk_run(d_in, d_out, d_ws, stream, 0, mk::PH_END, false);
}
```

```cpp
#include <hip/hip_runtime.h>
#include <cstdio>
#include <cstdint>
#include <cmath>
namespace pg8 {
#define PG8_LAS __attribute__((address_space(3)))
typedef unsigned short bf16_t;
typedef short bf16x8 __attribute__((ext_vector_type(8)));
typedef float f32x4 __attribute__((ext_vector_type(4)));
typedef float f32x2 __attribute__((ext_vector_type(2)));
typedef unsigned u32x4 __attribute__((ext_vector_type(4)));
typedef unsigned u32x2 __attribute__((ext_vector_type(2)));
typedef int i32x4 __attribute__((ext_vector_type(4)));
typedef int i32x8 __attribute__((ext_vector_type(8)));
constexpr int BM = 256, BK = 64, HALF = 128, HTB = HALF * BK * 2  , STAGE_BYTES = 8 * HTB, NXCD = 8, WGM = 8;

__host__ __device__ __forceinline__ int lds_byte(int r, int c) { const int st = (r >> 4) * 2 + (c >> 5), rr = r & 15, cc = c & 31, ob = rr * 64 + cc * 2; return st * 1024 + (ob ^ (((ob >> 9) & 1) << 5)); }
__host__ __device__ __forceinline__ void stage_rc(int b, int& R, int& C) { const int st = b / 1024, sb = b % 1024, swz = sb ^ (((sb >> 9) & 1) << 5); R = (st >> 1) * 16 + swz / 64; C = (st & 1) * 32 + (swz % 64) / 2; }
__host__ __device__ __forceinline__ int perm32(int rho) { const int n = rho >> 4, i = rho & 15; return 8 * (i >> 2) + 4 * n + (i & 3); }
__host__ __device__ __forceinline__ int perm256h(int rho) { const int wc = rho >> 5, n = (rho >> 4) & 1, i = rho & 15; return 64 * wc + 16 * (i >> 2) + 4 * n + (i & 3); }

struct Unit { int pm, pn; const char* A; const char* B; int e; int slot; };

struct DenseOrder {
    const char* A; const char* Bt; int K; int nM, nN, nwg, G, c; int lda, ldb;
    int pm_off, b_panels; size_t b_stride;
    __device__ void init(const void* A_, const void* Bt_, int M, int N, int K_, int G_, int c_) { A = (const char*)A_; Bt = (const char*)Bt_; K = K_; nM = M / BM; nN = N / BM; nwg = nM * nN; G = G_; c = c_; lda = K_; ldb = K_; pm_off = 0; b_panels = 0; b_stride = 0; }
    __device__ __forceinline__ bool next(int i, Unit& u) const {
        const long L = (long)i * G + c; if (L >= nwg) return false;
        int wgid = (int)L; { const int q = nwg / NXCD, r = nwg % NXCD, xcd = wgid % NXCD, off = wgid / NXCD; wgid = (xcd < r ? xcd * (q + 1) : r * (q + 1) + (xcd - r) * q) + off; }
        const int nig = WGM * nN, gid = wgid / nig, fm = gid * WGM, gsz = (nM - fm) < WGM ? (nM - fm) : WGM;
        u.pm = fm + ((wgid % nig) % gsz); u.pn = (wgid % nig) / gsz;
        u.A = A + (size_t)u.pm * BM * lda * 2; u.B = Bt + (size_t)u.pn * BM * ldb * 2 + (b_panels ? (size_t)((u.pm + pm_off) / b_panels) * b_stride : (size_t)0); u.e = 0; u.slot = i; return true;
    }
};

typedef __bf16 bf16x2_t __attribute__((ext_vector_type(2)));
__device__ __forceinline__ unsigned pk4_fp8(float a, float b, float c, float d) { int w = __builtin_amdgcn_cvt_pk_fp8_f32(a, b, 0, false); w = __builtin_amdgcn_cvt_pk_fp8_f32(c, d, w, true); return (unsigned)w; }
__device__ __forceinline__ unsigned cvt_pk_bf16(float lo, float hi) { const f32x2 v = {lo, hi}; const bf16x2_t r = __builtin_convertvector(v, bf16x2_t); return __builtin_bit_cast(unsigned, r); }


__device__ __forceinline__ void store_rows16(u32x4 w, unsigned char* g0, size_t pitch, int lane) {
    const int orow = 4 * (lane >> 4) + ((lane >> 2) & 3), och = lane & 3, src4 = 4 * (och * 16 + orow);
    u32x4 t; t.x = (unsigned)__builtin_amdgcn_ds_bpermute(src4, (int)w.x); t.y = (unsigned)__builtin_amdgcn_ds_bpermute(src4, (int)w.y); t.z = (unsigned)__builtin_amdgcn_ds_bpermute(src4, (int)w.z); t.w = (unsigned)__builtin_amdgcn_ds_bpermute(src4, (int)w.w);
    *(u32x4*)(g0 + (size_t)orow * pitch + och * 16) = t;
}
__device__ __forceinline__ void store_rows8(u32x2 w, unsigned char* g0, size_t pitch, int lane) {
    const int orow = 4 * (lane >> 4) + ((lane >> 2) & 3), och = lane & 3, src4 = 4 * (och * 16 + orow);
    u32x2 t; t.x = (unsigned)__builtin_amdgcn_ds_bpermute(src4, (int)w.x); t.y = (unsigned)__builtin_amdgcn_ds_bpermute(src4, (int)w.y);
    *(u32x2*)(g0 + (size_t)orow * pitch + och * 8) = t;
}
__device__ __forceinline__ void store_rows32(u32x4 w0, u32x4 w1, unsigned char* g0, size_t pitch, int lane) {
    const int i = lane & 15, P = i & 7;
#pragma unroll
    for (int k = 0; k < 2; ++k) { const int row = 8 * k + 2 * (lane >> 4) + (i >> 3), src4 = 4 * ((P >> 1) * 16 + row);
        u32x4 a, b; a.x = (unsigned)__builtin_amdgcn_ds_bpermute(src4, (int)w0.x); a.y = (unsigned)__builtin_amdgcn_ds_bpermute(src4, (int)w0.y); a.z = (unsigned)__builtin_amdgcn_ds_bpermute(src4, (int)w0.z); a.w = (unsigned)__builtin_amdgcn_ds_bpermute(src4, (int)w0.w);
        b.x = (unsigned)__builtin_amdgcn_ds_bpermute(src4, (int)w1.x); b.y = (unsigned)__builtin_amdgcn_ds_bpermute(src4, (int)w1.y); b.z = (unsigned)__builtin_amdgcn_ds_bpermute(src4, (int)w1.z); b.w = (unsigned)__builtin_amdgcn_ds_bpermute(src4, (int)w1.w);
        const u32x4 t = (P & 1) ? b : a;
        *(u32x4*)(g0 + (size_t)row * pitch + P * 16) = t; }
}

struct EpiBf16 {
    static constexpr int PERM = 1; static constexpr bool AFTER_DRAIN = false;
    bf16_t* O; int ldc; int split_cols; size_t split_stride; float scale0; size_t estride = 0;
    __device__ __forceinline__ void operator()(const f32x4 (&acc)[2][2][4][2], const Unit& u, int wr, int wc, int fr, int fq, PG8_LAS const int* tab) const {
        const int row0 = u.pm * BM + wr * 64 + fr; int colt = u.pn * BM; bf16_t* base = O + (size_t)u.e * estride;
        float sc = scale0; if (split_cols) { const int t = colt / split_cols; base += (size_t)t * split_stride; colt -= t * split_cols; if (t != 0) sc = 1.f; }
        const int lane = fq * 16 + fr; const size_t pitch = (size_t)ldc * 2;
        unsigned char* g00 = (unsigned char*)(base + (size_t)(row0 - fr) * ldc + colt + wc * 32);
#pragma unroll
        for (int ai = 0; ai < 2; ++ai)
#pragma unroll
            for (int m = 0; m < 4; ++m) {
#pragma unroll
                for (int bj = 0; bj < 2; ++bj) { f32x4 v0 = acc[ai][bj][m][0] * sc, v1 = acc[ai][bj][m][1] * sc;
                    u32x4 w; w.x = cvt_pk_bf16(v0[0], v0[1]); w.y = cvt_pk_bf16(v0[2], v0[3]); w.z = cvt_pk_bf16(v1[0], v1[1]); w.w = cvt_pk_bf16(v1[2], v1[3]);
                    store_rows16(w, g00 + (size_t)(ai * HALF + m * 16) * pitch + bj * HALF * 2, pitch, lane); } }
    }
};
struct EpiSwiGLU {
    static constexpr int PERM = 1; static constexpr bool AFTER_DRAIN = false;
    unsigned char* Hq; PG8_LAS const int* rowbase; float wscale; int dry;
    __device__ __forceinline__ void operator()(const f32x4 (&acc)[2][2][4][2], const Unit& u, int wr, int wc, int fr, int fq, PG8_LAS const int* tab) const {
        const int rb = __builtin_amdgcn_readfirstlane(rowbase[u.e]);
        const size_t row0 = (size_t)rb + u.pm * BM + wr * 64 + fr; const int col0 = u.pn * HALF + wc * 32 + 8 * fq;
#pragma unroll
        for (int ai = 0; ai < 2; ++ai)
#pragma unroll
            for (int m = 0; m < 4; ++m) { unsigned char* rowp = Hq + (row0 + ai * HALF + m * 16) * 512 + col0;
                float hv[8];
#pragma unroll
                for (int n = 0; n < 2; ++n)
#pragma unroll
                    for (int j = 0; j < 4; ++j) { const float g = acc[ai][0][m][n][j] * wscale, uu = acc[ai][1][m][n][j] * wscale;
                        hv[n * 4 + j] = g * __builtin_amdgcn_rcpf(1.0f + __builtin_amdgcn_exp2f(-1.44269504f * g)) * uu; }
                u32x2 w; w.x = pk4_fp8(hv[0], hv[1], hv[2], hv[3]); w.y = pk4_fp8(hv[4], hv[5], hv[6], hv[7]);
                if (!dry) store_rows8(w, rowp - (size_t)fr * 512 - 8 * fq, 512, fq * 16 + fr); }
    }
};
struct EpiDown {
    static constexpr int PERM = 2; static constexpr bool AFTER_DRAIN = false;
    unsigned char* Y; PG8_LAS const int* rowbase;
    static constexpr float ws = 1.0f / 32.0f;
    __device__ __forceinline__ void operator()(const f32x4 (&acc)[2][2][4][2], const Unit& u, int wr, int wc, int fr, int fq, PG8_LAS const int* tab) const {
        unsigned char* const yb = Y;
        const int rb = __builtin_amdgcn_readfirstlane(rowbase[u.e]);
        const int lane = fq * 16 + fr;
        const int orow = 4 * (lane >> 4) + ((lane >> 2) & 3), och = lane & 3;
        const int src4 = 4 * (och * 16 + orow);
        unsigned char* ybase = yb + ((size_t)rb + (size_t)u.pm * BM + wr * 64 + orow) * 2048 + u.pn * BM + wc * 64 + och * 16;
#pragma unroll
        for (int ai = 0; ai < 2; ++ai)
#pragma unroll
            for (int m = 0; m < 4; ++m) { const f32x4 v0 = acc[ai][0][m][0] * ws, v1 = acc[ai][0][m][1] * ws, v2 = acc[ai][1][m][0] * ws, v3 = acc[ai][1][m][1] * ws;
                u32x4 w; w.x = pk4_fp8(v0[0], v0[1], v0[2], v0[3]); w.y = pk4_fp8(v1[0], v1[1], v1[2], v1[3]); w.z = pk4_fp8(v2[0], v2[1], v2[2], v2[3]); w.w = pk4_fp8(v3[0], v3[1], v3[2], v3[3]);
                u32x4 t; t.x = (unsigned)__builtin_amdgcn_ds_bpermute(src4, (int)w.x); t.y = (unsigned)__builtin_amdgcn_ds_bpermute(src4, (int)w.y); t.z = (unsigned)__builtin_amdgcn_ds_bpermute(src4, (int)w.z); t.w = (unsigned)__builtin_amdgcn_ds_bpermute(src4, (int)w.w);
                __builtin_nontemporal_store(t, (u32x4*)(ybase + (size_t)(ai * HALF + m * 16) * 2048)); }
    }
};

struct EpiSoftmax {
    static constexpr int PERM = 1; static constexpr bool AFTER_DRAIN = false;
    bf16_t* P; int ldc; PG8_LAS f32x2* xt; const PG8_LAS f32x2* rt; const PG8_LAS f32x2* ct;
    __device__ __forceinline__ void operator()(f32x4 (&acc)[2][2][4][2], const Unit& u, int wr, int wc, int fr, int fq, PG8_LAS const int* tab) const {
        {
            f32x4 c1[2][2], c2[2][2];
#pragma unroll
            for (int bj = 0; bj < 2; ++bj)
#pragma unroll
                for (int n = 0; n < 2; ++n) { const PG8_LAS f32x4* cp = (const PG8_LAS f32x4*)(ct + bj * HALF + wc * 32 + 8 * fq + 4 * n); const f32x4 p0 = cp[0], p1 = cp[1];
                    c1[bj][n] = (f32x4){p0[0], p0[2], p1[0], p1[2]}; c2[bj][n] = (f32x4){p0[1], p0[3], p1[1], p1[3]}; }
#pragma unroll
            for (int ai = 0; ai < 2; ++ai)
#pragma unroll
                for (int m = 0; m < 4; ++m) { const f32x2 sr = rt[ai * HALF + wr * 64 + m * 16 + fr]; const float nm = -sr.x * sr.y;
#pragma unroll
                    for (int bj = 0; bj < 2; ++bj)
#pragma unroll
                        for (int n = 0; n < 2; ++n) acc[ai][bj][m][n] = acc[ai][bj][m][n] * sr.y + (c1[bj][n] * nm + c2[bj][n]); }
        }
        float mw[2][4];
#pragma unroll
        for (int ai = 0; ai < 2; ++ai)
#pragma unroll
            for (int m = 0; m < 4; ++m) { float mx = -INFINITY;
#pragma unroll
                for (int bj = 0; bj < 2; ++bj)
#pragma unroll
                    for (int n = 0; n < 2; ++n) { const f32x4 x = acc[ai][bj][m][n]; mx = fmaxf(mx, fmaxf(fmaxf(x[0], x[1]), fmaxf(x[2], x[3]))); }
                mx = fmaxf(mx, __shfl_xor(mx, 16)); mx = fmaxf(mx, __shfl_xor(mx, 32)); float s = 0.f;
#pragma unroll
                for (int bj = 0; bj < 2; ++bj)
#pragma unroll
                    for (int n = 0; n < 2; ++n) { f32x4 e;
#pragma unroll
                        for (int j = 0; j < 4; ++j) { e[j] = __builtin_amdgcn_exp2f(acc[ai][bj][m][n][j] - mx); s += e[j]; }
                        acc[ai][bj][m][n] = e; }
                s += __shfl_xor(s, 16); s += __shfl_xor(s, 32);
                mw[ai][m] = mx;
                if (fq == 0) xt[(ai * HALF + wr * 64 + m * 16 + fr) * 4 + wc] = (f32x2){mx, s}; }
        asm volatile("s_waitcnt lgkmcnt(0)" ::: "memory"); __builtin_amdgcn_s_barrier(); asm volatile("" ::: "memory");
        const int row0 = u.pm * BM + wr * 64 + fr, col0 = u.pn * BM + wc * 32 + 8 * fq;
#pragma unroll
        for (int ai = 0; ai < 2; ++ai)
#pragma unroll
            for (int m = 0; m < 4; ++m) { const int r = ai * HALF + wr * 64 + m * 16 + fr;
                const f32x2 a = xt[r * 4 + 0], b = xt[r * 4 + 1], c = xt[r * 4 + 2], d = xt[r * 4 + 3];
                const float M = fmaxf(fmaxf(a.x, b.x), fmaxf(c.x, d.x));
                const float L = a.y * __builtin_amdgcn_exp2f(a.x - M) + b.y * __builtin_amdgcn_exp2f(b.x - M) + c.y * __builtin_amdgcn_exp2f(c.x - M) + d.y * __builtin_amdgcn_exp2f(d.x - M);
                const float f = __builtin_amdgcn_exp2f(mw[ai][m] - M) * __builtin_amdgcn_rcpf(L);
                bf16_t* rowp = P + (size_t)(row0 + ai * HALF + m * 16) * ldc + col0;
#pragma unroll
                for (int bj = 0; bj < 2; ++bj) { const f32x4 v0 = acc[ai][bj][m][0] * f, v1 = acc[ai][bj][m][1] * f;
                    u32x4 w; w.x = cvt_pk_bf16(v0[0], v0[1]); w.y = cvt_pk_bf16(v0[2], v0[3]); w.z = cvt_pk_bf16(v1[0], v1[1]); w.w = cvt_pk_bf16(v1[2], v1[3]);
                    store_rows16(w, (unsigned char*)(rowp + bj * HALF - (size_t)fr * ldc - 8 * fq), (size_t)ldc * 2, fq * 16 + fr); } }
        asm volatile("s_waitcnt lgkmcnt(0)" ::: "memory"); __builtin_amdgcn_s_barrier(); asm volatile("" ::: "memory");
    }
};

template <bool LNRES, bool OUTB>
struct EpiResStats {
    static constexpr int PERM = 1; static constexpr bool AFTER_DRAIN = false;
    const bf16_t* Rb; float alpha; float* T; bf16_t* Tb; f32x2* st; const PG8_LAS f32x2* rs; const float* g; const float* bta;
    __device__ __forceinline__ void operator()(f32x4 (&acc)[2][2][4][2], const Unit& u, int wr, int wc, int fr, int fq, PG8_LAS const int* tab) const {
        float alpha = this->alpha; const bf16_t* Rb = this->Rb; float* T = this->T; bf16_t* Tb = this->Tb; f32x2* st = this->st; const float* g = this->g; const float* bta = this->bta;
        asm volatile("" : "+s"(alpha), "+s"(Rb), "+s"(T), "+s"(Tb), "+s"(st), "+s"(g), "+s"(bta));
        const int col0 = u.pn * BM + wc * 32 + 8 * fq;
        f32x4 gv[2][2], bv[2][2];
        if constexpr (LNRES) {
#pragma unroll
            for (int bj = 0; bj < 2; ++bj)
#pragma unroll
                for (int n = 0; n < 2; ++n) { gv[bj][n] = *(const f32x4*)(g + col0 + bj * HALF + 4 * n); bv[bj][n] = *(const f32x4*)(bta + col0 + bj * HALF + 4 * n); }
        }
#pragma unroll
        for (int ai = 0; ai < 2; ++ai)
#pragma unroll
            for (int m = 0; m < 4; ++m) { const int rl = ai * HALF + wr * 64 + m * 16 + fr, row = u.pm * BM + rl; const size_t roff = (size_t)row * 2048 + col0;
                f32x2 sr = (f32x2){0.f, 1.f}; if constexpr (LNRES) sr = rs[(u.slot & 1) * 256 + rl];
#pragma unroll
                for (int bj = 0; bj < 2; ++bj) { const u32x4 w = *(const u32x4*)(Rb + roff + bj * HALF);
                    f32x4 r0 = (f32x4){__builtin_bit_cast(float, w.x << 16), __builtin_bit_cast(float, w.x & 0xffff0000u), __builtin_bit_cast(float, w.y << 16), __builtin_bit_cast(float, w.y & 0xffff0000u)};
                    f32x4 r1 = (f32x4){__builtin_bit_cast(float, w.z << 16), __builtin_bit_cast(float, w.z & 0xffff0000u), __builtin_bit_cast(float, w.w << 16), __builtin_bit_cast(float, w.w & 0xffff0000u)};
                    if constexpr (LNRES) { r0 = (r0 - sr.x) * sr.y * gv[bj][0] + bv[bj][0]; r1 = (r1 - sr.x) * sr.y * gv[bj][1] + bv[bj][1]; }
                    acc[ai][bj][m][0] += r0 * alpha; acc[ai][bj][m][1] += r1 * alpha; }
                float s = 0.f;
#pragma unroll
                for (int bj = 0; bj < 2; ++bj)
#pragma unroll
                    for (int n = 0; n < 2; ++n) { const f32x4 x = acc[ai][bj][m][n]; s += (x[0] + x[1]) + (x[2] + x[3]); }
                s += __shfl_xor(s, 16); s += __shfl_xor(s, 32);
                const float mw = s * (1.0f / 64.0f); float q = 0.f;
#pragma unroll
                for (int bj = 0; bj < 2; ++bj)
#pragma unroll
                    for (int n = 0; n < 2; ++n) { const f32x4 d = acc[ai][bj][m][n] - mw; q += (d[0] * d[0] + d[1] * d[1]) + (d[2] * d[2] + d[3] * d[3]); }
                q += __shfl_xor(q, 16); q += __shfl_xor(q, 32);
                if (fq == 0) st[(size_t)row * 32 + u.pn * 4 + wc] = (f32x2){mw, q};
#pragma unroll
                for (int bj = 0; bj < 2; ++bj) {
                    if constexpr (OUTB) { const f32x4 o0 = acc[ai][bj][m][0], o1 = acc[ai][bj][m][1]; u32x4 w; w.x = cvt_pk_bf16(o0[0], o0[1]); w.y = cvt_pk_bf16(o0[2], o0[3]); w.z = cvt_pk_bf16(o1[0], o1[1]); w.w = cvt_pk_bf16(o1[2], o1[3]);
                        store_rows16(w, (unsigned char*)(Tb + roff + bj * HALF - (size_t)fr * 2048 - 8 * fq), 4096, fq * 16 + fr); }
                    else store_rows32(__builtin_bit_cast(u32x4, acc[ai][bj][m][0]), __builtin_bit_cast(u32x4, acc[ai][bj][m][1]), (unsigned char*)(T + roff + bj * HALF - (size_t)fr * 2048 - 8 * fq), 8192, fq * 16 + fr); }
                if (m & 1) asm volatile("" ::: "memory"); }
    }
};
struct EpiBt1 {
    static constexpr int PERM = 1; static constexpr bool AFTER_DRAIN = false;
    bf16_t* O; const float* g; const float* bta; f32x2* sp; float scale;
    __device__ __forceinline__ void operator()(const f32x4 (&acc)[2][2][4][2], const Unit& u, int wr, int wc, int fr, int fq, PG8_LAS const int* tab) const {
        const int col0 = u.pn * BM + wc * 32 + 8 * fq;
        f32x4 gv[2][2], bv[2][2];
#pragma unroll
        for (int bj = 0; bj < 2; ++bj)
#pragma unroll
            for (int n = 0; n < 2; ++n) { gv[bj][n] = *(const f32x4*)(g + col0 + bj * HALF + 4 * n); bv[bj][n] = *(const f32x4*)(bta + col0 + bj * HALF + 4 * n); }
#pragma unroll
        for (int ai = 0; ai < 2; ++ai)
#pragma unroll
            for (int m = 0; m < 4; ++m) { const int row = u.pm * BM + ai * HALF + wr * 64 + m * 16 + fr; const size_t roff = (size_t)row * 2048 + col0;
                float s1 = 0.f, s2 = 0.f;
#pragma unroll
                for (int bj = 0; bj < 2; ++bj) { const f32x4 v0 = acc[ai][bj][m][0] * scale, v1 = acc[ai][bj][m][1] * scale; const f32x4 o0 = v0 * gv[bj][0], o1 = v1 * gv[bj][1];
                    u32x4 w; w.x = cvt_pk_bf16(o0[0], o0[1]); w.y = cvt_pk_bf16(o0[2], o0[3]); w.z = cvt_pk_bf16(o1[0], o1[1]); w.w = cvt_pk_bf16(o1[2], o1[3]);
                    s1 += (__builtin_bit_cast(float, w.x << 16) + __builtin_bit_cast(float, w.x & 0xffff0000u)) + (__builtin_bit_cast(float, w.y << 16) + __builtin_bit_cast(float, w.y & 0xffff0000u))
                        + (__builtin_bit_cast(float, w.z << 16) + __builtin_bit_cast(float, w.z & 0xffff0000u)) + (__builtin_bit_cast(float, w.w << 16) + __builtin_bit_cast(float, w.w & 0xffff0000u));
                    const f32x4 t0 = v0 * bv[bj][0], t1 = v1 * bv[bj][1]; s2 += (t0[0] + t0[1]) + (t0[2] + t0[3]) + (t1[0] + t1[1]) + (t1[2] + t1[3]);
                    store_rows16(w, (unsigned char*)(O + roff + bj * HALF - (size_t)fr * 2048 - 8 * fq), 4096, fq * 16 + fr); }
                s1 += __shfl_xor(s1, 16); s1 += __shfl_xor(s1, 32); s2 += __shfl_xor(s2, 16); s2 += __shfl_xor(s2, 32);
                if (fq == 0) sp[(size_t)row * 32 + u.pn * 4 + wc] = (f32x2){s1, s2}; }
    }
};

__device__ __forceinline__ int fresh_lane() { int l; asm volatile("v_mbcnt_lo_u32_b32 %0, -1, 0\n\tv_mbcnt_hi_u32_b32 %0, -1, %0" : "=v"(l)); return l; }
template <class Epi, class Sched, bool GATHER, bool F8 = false>
__device__ __forceinline__ void gemm_phase(PG8_LAS unsigned char* lds, const int K, const Sched& S, const Epi& E, PG8_LAS const int* tab, const int wid  ) {
    const int lane = fresh_lane(), tid = wid * 64 + lane, wr = wid >> 2, wc = wid & 3, fr = lane & 15, fq = lane >> 4;
    const int nt = K / BK;
    unsigned voffB[2];
#pragma unroll
    for (int i = 0; i < 2; ++i) { int R, C; stage_rc(tid * 16 + i * 8192, R, C); const int Rb = Epi::PERM == 2 ? perm256h(R) : (Epi::PERM == 1 ? ((R & ~31) + perm32(R & 31)) : R); voffB[i] = (unsigned)(Rb * S.ldb + C) * 2u; }
    const size_t kstep = (size_t)(BK * 2);
    const size_t hstep = (size_t)(Epi::PERM == 2 ? 8 : HALF) * S.ldb * 2;
    const size_t hA1 = GATHER ? (size_t)0 : (size_t)HALF * S.lda * 2;
    const unsigned ldsw = (unsigned)wid * 1024u;
    const int aoff = lds_byte(wr * 64 + fr, fq * 8), boff = lds_byte(wc * 32 + fr, fq * 8);
#define PG8_SA(b, h) (((b) * 2 + (h)) * HTB)
#define PG8_SB(b, h) ((4 + (b) * 2 + (h)) * HTB)
#define PG8_STAGE(bufoff, gbase, voff) do { _Pragma("unroll") for (int _i = 0; _i < 2; ++_i) { unsigned _o = (voff)[_i]; asm volatile("" : "+v"(_o)); \
        __builtin_amdgcn_global_load_lds((const unsigned*)((const char*)(gbase) + _o), (PG8_LAS unsigned*)(lds + (bufoff) + ldsw + _i * 8192), 16, 0, 0); } } while (0)
#define PG8_LDA(dst, b, h) do { if constexpr (F8) { _Pragma("unroll") for (int m = 0; m < 4; ++m) { const i32x4 _p0 = *(const PG8_LAS i32x4*)(lds + PG8_SA(b, h) + aoff + m * 2048), _p1 = *(const PG8_LAS i32x4*)(lds + PG8_SA(b, h) + aoff + m * 2048 + 1024); dst##8[m] = __builtin_shufflevector(_p0, _p1, 0, 1, 2, 3, 4, 5, 6, 7); } } \
        else { _Pragma("unroll") for (int m = 0; m < 4; ++m) _Pragma("unroll") for (int k = 0; k < 2; ++k) dst[m][k] = *(const PG8_LAS bf16x8*)(lds + PG8_SA(b, h) + aoff + m * 2048 + k * 1024); } } while (0)
#define PG8_LDB(dst, b, h) do { if constexpr (F8) { _Pragma("unroll") for (int n = 0; n < 2; ++n) { const i32x4 _p0 = *(const PG8_LAS i32x4*)(lds + PG8_SB(b, h) + boff + n * 2048), _p1 = *(const PG8_LAS i32x4*)(lds + PG8_SB(b, h) + boff + n * 2048 + 1024); dst##8[n] = __builtin_shufflevector(_p0, _p1, 0, 1, 2, 3, 4, 5, 6, 7); } } \
        else { _Pragma("unroll") for (int n = 0; n < 2; ++n) _Pragma("unroll") for (int k = 0; k < 2; ++k) dst[n][k] = *(const PG8_LAS bf16x8*)(lds + PG8_SB(b, h) + boff + n * 2048 + k * 1024); } } while (0)
#define PG8_MMA(ai, bj, At, Bt) do { __builtin_amdgcn_s_setprio(1); _Pragma("unroll") for (int m = 0; m < 4; ++m) _Pragma("unroll") for (int n = 0; n < 2; ++n) { \
        if constexpr (F8) asm volatile("v_mfma_scale_f32_16x16x128_f8f6f4 %0, %1, %2, %0, %3, %3 op_sel_hi:[0,0,0]" : "+v"(acc[ai][bj][m][n]) : "v"(Bt##8[n]), "v"(At##8[m]), "v"(f8scale));   \
        else { _Pragma("unroll") for (int k = 0; k < 2; ++k) acc[ai][bj][m][n] = __builtin_amdgcn_mfma_f32_16x16x32_bf16(Bt[n][k], At[m][k], acc[ai][bj][m][n], 0, 0, 0); } } \
        __builtin_amdgcn_s_setprio(0); } while (0)
#define PG8_WAIT_V(n) asm volatile("s_waitcnt vmcnt(" #n ")" ::: "memory")
#define PG8_WAIT_L(n) asm volatile("s_waitcnt lgkmcnt(" #n ")" ::: "memory")
#define PG8_BAR __builtin_amdgcn_s_barrier()
#define PG8_SCHED __builtin_amdgcn_sched_barrier(0)
#define PG8_VOFF(u, v) do { const int _tid = wid * 64 + fresh_lane(); _Pragma("unroll") for (int _i = 0; _i < 2; ++_i) { int _R, _C; stage_rc(_tid * 16 + _i * 8192, _R, _C); \
        if (GATHER) { _Pragma("unroll") for (int _h = 0; _h < 2; ++_h) { const int _row = tab[(u).slot * 256 + _h * HALF + _R]; v[_h][_i] = (unsigned)_row * (unsigned)(S.lda * 2) + (unsigned)(_C * 2); } } \
        else v[0][_i] = (unsigned)(_R * S.lda + _C) * 2u; } } while (0)
    Unit cur, nxt; int ui = 0;
    if (!S.next(0, cur)) return;
    f32x4 acc[2][2][4][2];
#pragma unroll
    for (int a = 0; a < 2; ++a)
#pragma unroll
        for (int b = 0; b < 2; ++b)
#pragma unroll
            for (int m = 0; m < 4; ++m)
#pragma unroll
                for (int n = 0; n < 2; ++n) acc[a][b][m][n] = (f32x4){0.f, 0.f, 0.f, 0.f};
    const int f8scale = 0x7f7f7f7f;
    bf16x8 At[4][2], B0[2][2], B1[2][2]; i32x8 At8[4], B08[2], B18[2];
    unsigned vA[2][2];
#define PG8_VA1 (GATHER ? vA[1] : vA[0])
    PG8_VOFF(cur, vA);
    if (GATHER) PG8_WAIT_L(0);
    const char* cA = cur.A; const char* cB = cur.B;
    PG8_STAGE(PG8_SB(0, 0), cB, voffB); PG8_STAGE(PG8_SB(0, 1), cB + hstep, voffB); PG8_STAGE(PG8_SA(0, 0), cA, vA[0]); PG8_STAGE(PG8_SA(0, 1), cA + hA1, PG8_VA1);
    if (wr == 1) PG8_BAR;
    PG8_WAIT_V(2); PG8_BAR;
    PG8_STAGE(PG8_SB(1, 0), cB + kstep, voffB); PG8_STAGE(PG8_SA(1, 0), cA + kstep, vA[0]); PG8_STAGE(PG8_SB(1, 1), cB + hstep + kstep, voffB);
    PG8_WAIT_V(6); PG8_BAR;
    for (;;) {
        const bool has_next = S.next(ui + 1, nxt);
        const char* nA = has_next ? nxt.A : cA; const char* nB = has_next ? nxt.B : cB;
#pragma nounroll
        for (int t = 0; t < nt; t += 2) {
            const bool last = (t == nt - 2);
            const char* a1 = cA + (size_t)(t + 1) * kstep;
            const char* a2 = last ? nA : cA + (size_t)(t + 2) * kstep; const char* b2 = last ? nB : cB + (size_t)(t + 2) * kstep;
            const char* a3 = a2 + kstep; const char* b3 = b2 + kstep;
            PG8_LDB(B0, 0, 0); PG8_LDB(B1, 0, 1); PG8_SCHED; PG8_LDA(At, 0, 0); PG8_STAGE(PG8_SA(1, 1), a1 + hA1, PG8_VA1);
            if (GATHER && last && has_next) PG8_VOFF(nxt, vA);
            PG8_WAIT_V(8); PG8_WAIT_L(0); PG8_BAR; PG8_MMA(0, 0, At, B0); PG8_MMA(0, 1, At, B1); PG8_BAR; PG8_SCHED;
            PG8_LDA(At, 0, 1); PG8_STAGE(PG8_SB(0, 0), b2, voffB); PG8_STAGE(PG8_SB(0, 1), b2 + hstep, voffB); PG8_STAGE(PG8_SA(0, 0), a2, vA[0]);
            PG8_WAIT_V(8); PG8_WAIT_L(0); PG8_BAR; PG8_MMA(1, 0, At, B0); PG8_MMA(1, 1, At, B1); PG8_BAR; PG8_SCHED;
            PG8_LDB(B0, 1, 0); PG8_LDB(B1, 1, 1); PG8_SCHED; PG8_LDA(At, 1, 0); PG8_STAGE(PG8_SA(0, 1), a2 + hA1, PG8_VA1);
            PG8_WAIT_V(8); PG8_WAIT_L(0); PG8_BAR; PG8_MMA(0, 0, At, B0); PG8_MMA(0, 1, At, B1); PG8_BAR; PG8_SCHED;
            PG8_LDA(At, 1, 1); PG8_STAGE(PG8_SB(1, 0), b3, voffB); PG8_STAGE(PG8_SB(1, 1), b3 + hstep, voffB); PG8_STAGE(PG8_SA(1, 0), a3, vA[0]);
            PG8_WAIT_V(8); PG8_WAIT_L(0); PG8_BAR; PG8_MMA(1, 0, At, B0); PG8_MMA(1, 1, At, B1); PG8_BAR; PG8_SCHED;
        }
        if constexpr (F8) asm volatile("s_nop 15\n\ts_nop 15" ::: "memory");
        if (wr == 0) PG8_BAR;
        if constexpr (!Epi::AFTER_DRAIN) { const int _l = fresh_lane(); E(acc, cur, wr, wc, _l & 15, _l >> 4, tab); }
        if (!has_next) break;
#pragma unroll
        for (int a = 0; a < 2; ++a)
#pragma unroll
            for (int b = 0; b < 2; ++b)
#pragma unroll
                for (int m = 0; m < 4; ++m)
#pragma unroll
                    for (int n = 0; n < 2; ++n) acc[a][b][m][n] = (f32x4){0.f, 0.f, 0.f, 0.f};
        cur = nxt; cA = nA; cB = nB; ++ui;
        if (wr == 1) PG8_BAR;
    }
    PG8_WAIT_V(0);
    PG8_BAR;
    if constexpr (Epi::AFTER_DRAIN) { const int _l = fresh_lane(); E.fused(acc, cur, wr, wc, _l & 15, _l >> 4, lds, wid, _l); }
#undef PG8_SA
#undef PG8_SB
#undef PG8_STAGE
#undef PG8_LDA
#undef PG8_LDB
#undef PG8_MMA
#undef PG8_WAIT_V
#undef PG8_WAIT_L
#undef PG8_BAR
#undef PG8_SCHED
#undef PG8_VOFF
#undef PG8_VA1
}
}
namespace mk {
#define GAS __attribute__((address_space(1)))
#define LAS __attribute__((address_space(3)))
typedef unsigned short bf16;
typedef unsigned u32x4 __attribute__((ext_vector_type(4)));
typedef unsigned u32x2 __attribute__((ext_vector_type(2)));
typedef float f32x4 __attribute__((ext_vector_type(4)));
typedef short bf16x8 __attribute__((ext_vector_type(8)));
typedef short s16x4 __attribute__((ext_vector_type(4)));
typedef GAS unsigned gu32;
#define RLX_AGENT __ATOMIC_RELAXED, __HIP_MEMORY_SCOPE_AGENT
#define LDS_WAIT() asm volatile("s_waitcnt lgkmcnt(0)" ::: "memory")
#define VM_WAIT() asm volatile("s_waitcnt vmcnt(0)" ::: "memory")

constexpr int NWAVES = 8;
constexpr int NTOK = 16384, DM = 2048, SEQL = 4096, NB = 4, AW = 1024, HD = 128, NH = 8, INC = 6144;
constexpr int MEML = 256, NMH = 4, MHD = 512, NE = 64, NEX = 65  , TOPK = 8, FF = 512, CAP = 16384;
constexpr float LN_EPS = 1e-5f, RMS_EPS = 1e-6f, ALPHA = 1.189207115002721f;
constexpr float QSCALE = 0.08838834764831845f * 1.4426950408889634f;
constexpr float MQSCALE = 0.04419417382415922f * 1.4426950408889634f;
constexpr float WPRE = 32.0f, WPOST = 1.0f / 32.0f;
constexpr int HROWS = 131072 + 64 * 256 + 16384;

constexpr size_t MiB = 1u << 20;
constexpr size_t WS_CTL = 0, CTL_ZERO_BYTES = 256 * 1024;
constexpr size_t WS_XCH = 1 * MiB;
constexpr size_t WS_WD = 2 * MiB;
constexpr size_t WS_WGU = 132 * MiB;
constexpr size_t WS_Y = 132 * MiB;
constexpr size_t WS_WIN = 392 * MiB, WS_WOUT = 416 * MiB, WS_WQ = 424 * MiB, WS_WKV = 432 * MiB, WS_WO = 448 * MiB, WS_WR = 456 * MiB;
constexpr size_t WS_OG = 457 * MiB;
constexpr size_t WS_QM = 457 * MiB, WS_OM = 521 * MiB;
constexpr size_t WS_S12 = 392 * MiB;
constexpr size_t WS_ST1 = 393 * MiB;
constexpr size_t WS_ST2 = 489 * MiB;
constexpr size_t WS_P = 457 * MiB;
constexpr size_t WS_BT1 = 617 * MiB;
constexpr size_t WS_BT2 = 1016 * MiB;
constexpr size_t WS_MIXED = 553 * MiB;
constexpr size_t WS_XB = 644 * MiB, WS_MB = 708 * MiB;
constexpr size_t WS_T = 644 * MiB;
constexpr size_t WS_H = 644 * MiB;
constexpr size_t WS_PROJ = 804 * MiB;
constexpr size_t WS_X1 = 804 * MiB;
constexpr size_t WS_X1B = 932 * MiB;
constexpr size_t WS_X2Q = 553 * MiB;
constexpr size_t WS_KVM = 996 * MiB;
constexpr size_t WS_LSE = 1004 * MiB;
constexpr size_t WS_GATES = 1006 * MiB;
constexpr size_t WS_LTOK = 1007 * MiB, WS_LSLOT = 1011 * MiB;
constexpr size_t WS_END = 1032 * MiB;
constexpr int CW_TMO = 0, CW_CODE = 1, CW_BAR = 4096, CW_CNT = 16384, CW_SEAM = 32768, SEAM_BANK = 8192;
static_assert((size_t)(CW_SEAM + 2 * SEAM_BANK) * 4 <= CTL_ZERO_BYTES && CW_BAR + 3456 <= CW_CNT && CW_CNT + 64 * 64 <= CW_SEAM, "control words inside the per-call memset");

constexpr int RING_OFF = 0, RING_BYTES = 131072, TAB_OFF = 131072, TAB_BYTES = 28672, MISC_OFF = TAB_OFF + TAB_BYTES, MISC_BYTES = 2048;
constexpr int LDS_BYTES = MISC_OFF + MISC_BYTES;
constexpr int MAXU = 24;
constexpr int MW_PRE = 16, MW_RB = 96, MW_CNT = 176, MW_UL = 256, MW_NM = 300;

__device__ __forceinline__ unsigned f2bf(float f) { unsigned u = __builtin_bit_cast(unsigned, f); return (u + 0x7fffu + ((u >> 16) & 1u)) >> 16; }
__device__ __forceinline__ unsigned pk2(float lo, float hi) { return pg8::cvt_pk_bf16(lo, hi); }
__device__ __forceinline__ float bf2f(unsigned short b) { return __builtin_bit_cast(float, (unsigned)b << 16); }
__device__ __forceinline__ float bflo(unsigned w) { return __builtin_bit_cast(float, w << 16); }
__device__ __forceinline__ float bfhi(unsigned w) { return __builtin_bit_cast(float, w & 0xffff0000u); }

#define XB_TMO      128
#define XB_XCNT(j)  (256  + 64 * (j))
#define XB_XSUB(j)  (1280 + 64 * (j))
#define XB_XGEN(j)  (2304 + 64 * (j))
#define XB_TOP      3328
#define XB_TOPGEN   3392
#define XCD_BAR_WORDS 3456
#define XB_SPIN_CAP (1u << 18)
__device__ __forceinline__ unsigned xb_ld(unsigned* p)              { return __hip_atomic_load(p, __ATOMIC_RELAXED, __HIP_MEMORY_SCOPE_AGENT); }
__device__ __forceinline__ unsigned xb_add(unsigned* p, unsigned v) { return __hip_atomic_fetch_add(p, v, __ATOMIC_RELAXED, __HIP_MEMORY_SCOPE_AGENT); }
__device__ __forceinline__ unsigned xb_xcc_id() { return (unsigned)__builtin_amdgcn_s_getreg((3 << 11) | 20) & 0xFu; }
#define XB_SPIN(cond, bar) do { unsigned _sp = 0; while (cond) { __builtin_amdgcn_s_sleep(1); \
    if ((++_sp & 255u) == 0u) { if (xb_ld(&(bar)[XB_TMO])) break; if (_sp > XB_SPIN_CAP) { atomicAdd(&(bar)[XB_TMO], 1u); break; } } } } while (0)
struct XcdBarrier { unsigned* bar; unsigned x; volatile LAS unsigned* st; int wave; };
__device__ __forceinline__ bool xb_thread0(int wave) { return wave == 0 && pg8::fresh_lane() == 0; }
__device__ __forceinline__ XcdBarrier xcd_barrier_post(unsigned* bar, volatile LAS unsigned* st, int wave) {
    XcdBarrier b; b.bar = bar; b.x = xb_xcc_id(); b.st = st; b.wave = wave;
    if (xb_thread0(wave)) (void)xb_add(&bar[XB_XCNT(b.x)], 1u);
    return b;
}
__device__ __forceinline__ void xcd_barrier_complete(unsigned* bar, unsigned x, unsigned& nloc, unsigned& nx) {
    const unsigned G = gridDim.x * gridDim.y * gridDim.z;
    unsigned sum, cnt, mine, sp = 0u;
    for (;;) {
        sum = 0u; cnt = 0u; mine = 0u;
#pragma unroll
        for (unsigned j = 0; j < 16; ++j) { const unsigned c = xb_ld(&bar[XB_XCNT(j)]); sum += c; cnt += (c > 0u) ? 1u : 0u; mine = (j == x) ? c : mine; }
        if (sum == G) break;
        __builtin_amdgcn_s_sleep(1);
        if ((++sp & 255u) == 0u) { if (xb_ld(&bar[XB_TMO])) break; if (sp > XB_SPIN_CAP) { atomicAdd(&bar[XB_TMO], 1u); break; } }
    }
    nloc = mine > 0u ? mine : 1u; nx = cnt > 0u ? cnt : 1u;
}
__device__ __forceinline__ void xcd_barrier(const XcdBarrier& b) {
    asm volatile("s_waitcnt vmcnt(0)" ::: "memory");
    __syncthreads();
    if (xb_thread0(b.wave)) {
        unsigned* bar = b.bar;
        __builtin_amdgcn_s_waitcnt(0);
        unsigned nloc = b.st[0], nx = b.st[1];
        if (nloc == 0u) { xcd_barrier_complete(bar, b.x, nloc, nx); b.st[0] = nloc; b.st[1] = nx; }
        const unsigned old = xb_add(&bar[XB_XSUB(b.x)], 1u);
        const unsigned gen = old / nloc;
        if (old + 1u == (gen + 1u) * nloc) {
            __builtin_amdgcn_fence(__ATOMIC_RELEASE, "agent");
            asm volatile("s_waitcnt vmcnt(0)" ::: "memory");
            const unsigned og = xb_add(&bar[XB_TOP], 1u);
            const unsigned tg = og / nx;
            if (og + 1u == (tg + 1u) * nx) xb_add(&bar[XB_TOPGEN], 1u);
            else XB_SPIN(xb_ld(&bar[XB_TOPGEN]) == tg, bar);
            __builtin_amdgcn_fence(__ATOMIC_ACQUIRE, "agent");
            xb_add(&bar[XB_XGEN(b.x)], 1u);
            asm volatile("s_waitcnt vmcnt(0)" ::: "memory");
        } else {
            XB_SPIN(xb_ld(&bar[XB_XGEN(b.x)]) == gen, bar);
            __builtin_amdgcn_fence(__ATOMIC_ACQUIRE, "agent");
            asm volatile("s_waitcnt vmcnt(0)" ::: "memory");
        }
    }
    __syncthreads();
}

struct Args { const float* in[24]; float* out; unsigned char* ws; int ph_lo, ph_hi, use_bar, pad; };
struct Frame {
    LAS unsigned char* lds; volatile LAS unsigned* MISC; gu32* ctl; unsigned char* ws;
    int wave, vcu, G;
    __device__ __forceinline__ int lane_() const { return pg8::fresh_lane(); }
};
#define F_LANE(F) ((F).lane_())
#define F_TID(F) ((F).wave * 64 + (F).lane_())
__device__ __forceinline__ float wave_sum(float v) {
#pragma unroll
    for (int o = 1; o < 64; o <<= 1) v += __shfl_xor(v, o);
    return v;
}

__device__ __forceinline__ void p0_tr_item(const float* W, int ldw, int K, bf16* WT, int k0, int n0, int drow0, LAS float* scr, int lane) {
    f32x4 v[16];
    const float* src = W + (size_t)(k0 + (lane >> 4)) * ldw + n0 + 4 * (lane & 15);
#pragma unroll
    for (int p = 0; p < 16; ++p) v[p] = __builtin_nontemporal_load((const GAS f32x4*)(src + (size_t)(p * 4) * ldw));
#pragma unroll
    for (int p = 0; p < 16; ++p) { const int kk = p * 4 + (lane >> 4); LAS float* d = scr + kk * 65 + 4 * (lane & 15); d[0] = v[p].x; d[1] = v[p].y; d[2] = v[p].z; d[3] = v[p].w; }
    LDS_WAIT(); asm volatile("" ::: "memory");
    const int c = lane & 7;
#pragma unroll
    for (int j = 0; j < 8; ++j) { const int n = (lane >> 3) + 8 * j; const LAS float* s = scr + (8 * c) * 65 + n;
        u32x4 o; o.x = pk2(s[0 * 65], s[1 * 65]); o.y = pk2(s[2 * 65], s[3 * 65]); o.z = pk2(s[4 * 65], s[5 * 65]); o.w = pk2(s[6 * 65], s[7 * 65]);
        *(GAS u32x4*)(WT + (size_t)(drow0 + n) * K + k0 + 8 * c) = o; }
    LDS_WAIT(); asm volatile("" ::: "memory");
}
struct F8Item { const float* src; int ldw; unsigned char* dst; int K; };
__device__ __forceinline__ void p0_f8_load(const F8Item& d, int lane, f32x4 (&v)[16]) {
    const float* src = d.src + (size_t)(lane >> 4) * d.ldw + 4 * (lane & 15);
#pragma unroll
    for (int p = 0; p < 16; ++p) v[p] = __builtin_nontemporal_load((const GAS f32x4*)(src + (size_t)(p * 4) * d.ldw));
}
__device__ __forceinline__ void p0_f8_finish(const F8Item& d, int lane, const f32x4 (&v)[16], LAS float* scr, float scale) {
#pragma unroll
    for (int p = 0; p < 16; ++p) { const int kk = p * 4 + (lane >> 4); LAS float* q = scr + kk * 65 + 4 * (lane & 15); q[0] = v[p].x * scale; q[1] = v[p].y * scale; q[2] = v[p].z * scale; q[3] = v[p].w * scale; }
    LDS_WAIT(); asm volatile("" ::: "memory");
    const int c = lane & 3;
#pragma unroll
    for (int j = 0; j < 4; ++j) { const int n = (lane >> 2) + 16 * j; const LAS float* s = scr + (16 * c) * 65 + n;
        u32x4 o; o.x = pg8::pk4_fp8(s[0 * 65], s[1 * 65], s[2 * 65], s[3 * 65]); o.y = pg8::pk4_fp8(s[4 * 65], s[5 * 65], s[6 * 65], s[7 * 65]);
        o.z = pg8::pk4_fp8(s[8 * 65], s[9 * 65], s[10 * 65], s[11 * 65]); o.w = pg8::pk4_fp8(s[12 * 65], s[13 * 65], s[14 * 65], s[15 * 65]);
        __builtin_nontemporal_store(o, (GAS u32x4*)(d.dst + (size_t)n * d.K + 16 * c)); }
    LDS_WAIT(); asm volatile("" ::: "memory");
}
struct F8Ctx { const float *wg, *wu, *wd, *wsg, *wsu, *wsd; unsigned char *Wgu_t, *Wd_t; };
__device__ __forceinline__ F8Item p0_f8_decode(const F8Ctx& c, int r) {
    constexpr int I_GU = 32 * 8, I_D = 8 * 32; F8Item d;
    const int e = r / (2 * I_GU + I_D); int q = r % (2 * I_GU + I_D);
    if (q < 2 * I_GU) { const int up = q >= I_GU; if (up) q -= I_GU; const int kb = q / 8, nb = q % 8;
        const float* W = (e < NE) ? (up ? c.wu : c.wg) + (size_t)e * DM * FF : (up ? c.wsu : c.wsg);
        const int n0 = nb * 64, drow0 = (n0 >> 7) * 256 + (up ? 128 : 0) + (n0 & 127);
        d.src = W + (size_t)(kb * 64) * FF + n0; d.ldw = FF; d.K = DM; d.dst = c.Wgu_t + (size_t)e * 1024 * DM + (size_t)drow0 * DM + kb * 64;
    } else { q -= 2 * I_GU; const int kb = q / 32, nb = q % 32;
        const float* W = (e < NE) ? c.wd + (size_t)e * FF * DM : c.wsd;
        d.src = W + (size_t)(kb * 64) * DM + nb * 64; d.ldw = DM; d.K = FF; d.dst = c.Wd_t + (size_t)e * DM * FF + (size_t)(nb * 64) * FF + kb * 64; }
    return d;
}
#ifndef P0_FRAC16
#define P0_FRAC16 2
#endif
__device__ __forceinline__ void p0_prologue(Frame& F, const Args& a, int part, int gw, int NGW) {
    const int f_lane = F_LANE(F);
    LAS float* scr = (LAS float*)(F.lds + F.wave * 16640);
    const size_t gt = (size_t)gw * 64 + f_lane, NT = (size_t)NGW * 64;
    const float* x = a.in[0]; const float* mem = a.in[1]; const float* w_in = a.in[2]; const float* w_out = a.in[6]; const float* wq = a.in[9]; const float* wkv = a.in[10]; const float* wo = a.in[11];
    const float* wr = a.in[14]; const float* wg = a.in[16]; const float* wu = a.in[17]; const float* wd = a.in[18]; const float* wsg = a.in[19]; const float* wsu = a.in[20]; const float* wsd = a.in[21];
    bf16* Win_t = (bf16*)(F.ws + WS_WIN); bf16* Wout_t = (bf16*)(F.ws + WS_WOUT); bf16* Wq_t = (bf16*)(F.ws + WS_WQ); bf16* Wkv_t = (bf16*)(F.ws + WS_WKV); bf16* Wo_t = (bf16*)(F.ws + WS_WO);
    unsigned char* Wgu_t = (unsigned char*)(F.ws + WS_WGU); unsigned char* Wd_t = (unsigned char*)(F.ws + WS_WD);
    constexpr int I_GU = 32 * 8, I_D = 8 * 32;
    constexpr int I_EXP = NEX * (2 * I_GU + I_D);
    constexpr int I_IN = 32 * 96, I_SQ = 32 * 32, I_KV = 32 * 64;
    if (part == 0) {
        for (int r = gw; r < I_IN; r += NGW) p0_tr_item(w_in, INC, DM, Win_t, (r / 96) * 64, (r % 96) * 64, (r % 96) * 64, scr, f_lane);
        bf16* Xb = (bf16*)(F.ws + WS_XB);
        for (size_t i = gt; i < (size_t)NTOK * DM / 4; i += 4 * NT) {
            f32x4 v[4];
#pragma unroll
            for (int k = 0; k < 4; ++k) { const size_t q = i + (size_t)k * NT; v[k] = (q < (size_t)NTOK * DM / 4) ? __builtin_nontemporal_load((const GAS f32x4*)(x + q * 4)) : (f32x4){0.f, 0.f, 0.f, 0.f}; }
#pragma unroll
            for (int k = 0; k < 4; ++k) { const size_t q = i + (size_t)k * NT; if (q < (size_t)NTOK * DM / 4) { u32x2 o; o.x = pk2(v[k].x, v[k].y); o.y = pk2(v[k].z, v[k].w); *(GAS u32x2*)(Xb + q * 4) = o; } } }
    }
    constexpr int E_PRO = (I_EXP / 16) * P0_FRAC16;
    const int e0 = part == 0 ? 0 : E_PRO, e1 = part == 0 ? E_PRO : I_EXP;
    if (part == 1) {
    constexpr int NITEMS = I_KV + 2 * I_SQ + I_EXP;
    { bf16* Mb = (bf16*)(F.ws + WS_MB);
      for (size_t i = gt; i < (size_t)NB * MEML * DM / 8; i += NT) { const f32x4 v0 = *(const GAS f32x4*)(mem + i * 8), v1 = *(const GAS f32x4*)(mem + i * 8 + 4);
          u32x4 o; o.x = pk2(v0.x, v0.y); o.y = pk2(v0.z, v0.w); o.z = pk2(v1.x, v1.y); o.w = pk2(v1.z, v1.w); *(GAS u32x4*)(Mb + i * 8) = o; }
      for (size_t i = gt; i < (size_t)DM * DM / 8; i += NT) { const f32x4 v0 = *(const GAS f32x4*)(wq + i * 8), v1 = *(const GAS f32x4*)(wq + i * 8 + 4);
          u32x4 o; o.x = pk2(v0.x, v0.y); o.y = pk2(v0.z, v0.w); o.z = pk2(v1.x, v1.y); o.w = pk2(v1.z, v1.w); *(GAS u32x4*)(Wq_t + i * 8) = o; }
      bf16* Wr = (bf16*)(F.ws + WS_WR);
      for (size_t i = gt; i < (size_t)NE * DM; i += NT) { const int e = (int)(i / DM), k = (int)(i % DM); const float w = wr[(size_t)k * NE + e]; const unsigned h = f2bf(w); const float lo = w - __builtin_bit_cast(float, h << 16);
          Wr[i] = (bf16)h; Wr[(size_t)NE * DM + i] = (bf16)f2bf(lo); } }
    constexpr int NDENSE = I_KV + 2 * I_SQ; (void)NITEMS;
    for (int r = gw; r < NDENSE; r += NGW) {
        if (r < I_KV) p0_tr_item(wkv, 2 * DM, DM, Wkv_t, (r / 64) * 64, (r % 64) * 64, (r % 64) * 64, scr, f_lane);
        else if (r < I_KV + I_SQ) { const int q = r - I_KV; p0_tr_item(w_out, DM, DM, Wout_t, (q / 32) * 64, (q % 32) * 64, (q % 32) * 64, scr, f_lane); }
        else { const int q = r - I_KV - I_SQ; p0_tr_item(wo, DM, DM, Wo_t, (q / 32) * 64, (q % 32) * 64, (q % 32) * 64, scr, f_lane); }
    }
    }
    if (e0 + gw < e1) {
        const F8Ctx cx{wg, wu, wd, wsg, wsu, wsd, Wgu_t, Wd_t};
        f32x4 va[16], vb[16];
        F8Item da = p0_f8_decode(cx, e0 + gw), db = da; int it = e0 + gw;
        p0_f8_load(da, f_lane, va);
        for (;;) {
            const int n1 = it + NGW; const bool h1 = n1 < e1;
            if (h1) { db = p0_f8_decode(cx, n1); p0_f8_load(db, f_lane, vb); }
            __builtin_amdgcn_sched_barrier(0);
            p0_f8_finish(da, f_lane, va, scr, WPRE);
            if (!h1) break;
            const int n2 = n1 + NGW; const bool h2 = n2 < e1;
            if (h2) { da = p0_f8_decode(cx, n2); p0_f8_load(da, f_lane, va); }
            __builtin_amdgcn_sched_barrier(0);
            p0_f8_finish(db, f_lane, vb, scr, WPRE);
            if (!h2) break;
            it = n2;
        }
    }
}

constexpr int DA_KVU = 8;
constexpr int DA_STRIDE = 288, DA_KOFF = 0, DA_VOFF = 256 * DA_STRIDE;
struct DaUnit { int b, h, g, d, r, n; };
__device__ __forceinline__ DaUnit da_decode(int uid) { DaUnit q; const int bh = uid / 96, k96 = uid % 96; q.g = k96 >> 5; const int rem = k96 & 31, tps = 32 >> (2 * q.g);
    q.d = 1 << (2 * q.g); q.r = rem / tps; q.n = rem % tps; q.b = bh >> 3; q.h = bh & 7; return q; }
__device__ __forceinline__ void da_load(Frame& F, const DaUnit& q, int tid, u32x4 (&kr)[8], u32x4 (&vr)[8]) {
    const bf16* Kp = (const bf16*)(F.ws + WS_PROJ) + (size_t)NTOK * AW; const bf16* Vp = Kp + (size_t)NTOK * AW;
#pragma unroll
    for (int p = 0; p < 8; ++p) { const int kb = p * 32 + (tid >> 4), ch = tid & 15, ki = 128 * q.n - 128 + kb;
        if (ki >= 0) { const size_t off = ((size_t)(q.b * SEQL + ki * q.d + q.r)) * AW + q.h * HD + ch * 8; kr[p] = *(const GAS u32x4*)(Kp + off); vr[p] = *(const GAS u32x4*)(Vp + off); }
        else { kr[p] = (u32x4){0u, 0u, 0u, 0u}; vr[p] = kr[p]; } }
}
__device__ __forceinline__ void da_compute(Frame& F, const DaUnit& q, const bf16x8 (&qf)[4], size_t tq, int lane) {
    bf16* og = (bf16*)(F.ws + WS_OG); float* lse = (float*)(F.ws + WS_LSE);
    const int w = F.wave, fr = lane & 15, fq = lane >> 4, n = q.n, g = q.g, h = q.h;
    LAS unsigned char* lds = F.lds;
    const int kstart = 32 * (w >> 1);
    f32x4 S[10];
#pragma unroll
    for (int T = 0; T < 10; ++T) { S[T] = (f32x4){0.f, 0.f, 0.f, 0.f};
#pragma unroll
        for (int ks = 0; ks < 4; ++ks) { const bf16x8 kf = *(const LAS bf16x8*)(lds + DA_KOFF + (kstart + 16 * T + fr) * DA_STRIDE + (32 * ks + 8 * fq) * 2);
            S[T] = __builtin_amdgcn_mfma_f32_16x16x32_bf16(kf, qf[ks], S[T], 0, 0, 0); } }
    const int c0 = 128 + 16 * w + fr - kstart - 4 * fq; const unsigned span = (n > 0) ? 128u : (unsigned)(16 * w + fr);
    float mx = -INFINITY;
#pragma unroll
    for (int T = 0; T < 10; ++T)
#pragma unroll
        for (int j = 0; j < 4; ++j) { const bool ok = (unsigned)(c0 - (16 * T + j)) <= span;
            S[T][j] = ok ? S[T][j] : -INFINITY; mx = fmaxf(mx, S[T][j]); }
    mx = fmaxf(mx, __shfl_xor(mx, 16)); mx = fmaxf(mx, __shfl_xor(mx, 32));
    float sum = 0.f;
#pragma unroll
    for (int T = 0; T < 10; ++T)
#pragma unroll
        for (int j = 0; j < 4; ++j) { const float p = __builtin_amdgcn_exp2f(S[T][j] - mx); S[T][j] = p; sum += p; }
    sum += __shfl_xor(sum, 16); sum += __shfl_xor(sum, 32);
    bf16x8 pf[5];
#pragma unroll
    for (int s = 0; s < 5; ++s) { u32x4 wv; wv.x = pk2(S[2 * s][0], S[2 * s][1]); wv.y = pk2(S[2 * s][2], S[2 * s][3]); wv.z = pk2(S[2 * s + 1][0], S[2 * s + 1][1]); wv.w = pk2(S[2 * s + 1][2], S[2 * s + 1][3]); pf[s] = __builtin_bit_cast(bf16x8, wv); }
    f32x4 O[8];
#pragma unroll
    for (int dt = 0; dt < 8; ++dt) O[dt] = (f32x4){0.f, 0.f, 0.f, 0.f};
    const int q4 = fr >> 2, p4 = fr & 3;
    LAS unsigned char* vbase = lds + DA_VOFF + (kstart + 4 * fq + q4) * DA_STRIDE + p4 * 8;
#pragma unroll
    for (int s = 0; s < 5; ++s)
#pragma unroll
        for (int dt = 0; dt < 8; ++dt) {
            const s16x4 lo = __builtin_amdgcn_ds_read_tr16_b64_v4i16((LAS s16x4*)(vbase + (32 * s) * DA_STRIDE + dt * 32));
            const s16x4 hi = __builtin_amdgcn_ds_read_tr16_b64_v4i16((LAS s16x4*)(vbase + (32 * s + 16) * DA_STRIDE + dt * 32));
            const bf16x8 vf = {lo[0], lo[1], lo[2], lo[3], hi[0], hi[1], hi[2], hi[3]};
            O[dt] = __builtin_amdgcn_mfma_f32_16x16x32_bf16(vf, pf[s], O[dt], 0, 0, 0); }
    const float inv = 1.0f / sum;
    bf16* orow = og + ((size_t)g * NTOK + tq) * AW + h * HD + 4 * fq;
#pragma unroll
    for (int dt = 0; dt < 8; ++dt) { u32x2 o; o.x = pk2(O[dt][0] * inv, O[dt][1] * inv); o.y = pk2(O[dt][2] * inv, O[dt][3] * inv); *(GAS u32x2*)(orow + 16 * dt) = o; }
    if (fq == 0) lse[((size_t)g * NTOK + tq) * NH + h] = mx + __builtin_amdgcn_logf(sum);
}
__device__ __forceinline__ void dattn_phase(Frame& F, int u0, int ustride, int NU) {
    int u = u0; if (u >= NU) return;
    const int lane = F_LANE(F), tid = F.wave * 64 + lane, fr = lane & 15, fq = lane >> 4;
    const bf16* Qp = (const bf16*)(F.ws + WS_PROJ);
    LAS unsigned char* lds = F.lds;
    u32x4 kr[8], vr[8];
    DaUnit q = da_decode(u);
    da_load(F, q, tid, kr, vr);
    for (;;) {
#pragma unroll
        for (int p = 0; p < 8; ++p) { const int kb = p * 32 + (tid >> 4), ch = tid & 15;
            *(LAS u32x4*)(lds + DA_KOFF + kb * DA_STRIDE + ch * 16) = kr[p]; *(LAS u32x4*)(lds + DA_VOFF + kb * DA_STRIDE + ch * 16) = vr[p]; }
        const int qi = 128 * q.n + 16 * F.wave + fr; const size_t tq = (size_t)(q.b * SEQL + qi * q.d + q.r);
        bf16x8 qf[4];
#pragma unroll
        for (int ks = 0; ks < 4; ++ks) qf[ks] = *(const GAS bf16x8*)(Qp + tq * AW + q.h * HD + 32 * ks + 8 * fq);
        __syncthreads();
        const int un = u + ustride; const bool has = un < NU; DaUnit qn = q;
        if (has) { qn = da_decode(un); da_load(F, qn, tid, kr, vr); }
        __builtin_amdgcn_sched_barrier(0);
        da_compute(F, q, qf, tq, lane);
        __syncthreads();
        if (!has) break;
        u = un; q = qn;
    }
}

__device__ __forceinline__ void p3_token(Frame& F, const Args& a, int t) {
    const int f_lane = F_LANE(F), f_tid = F.wave * 64 + f_lane; (void)f_tid;
    const bf16* proj = (const bf16*)(F.ws + WS_PROJ); const bf16* og = (const bf16*)(F.ws + WS_OG); const float* lse = (const float*)(F.ws + WS_LSE);
    bf16* mixed = (bf16*)(F.ws + WS_MIXED);
    const float* conv_w = a.in[3]; const float* g_attn = a.in[4]; const float* g_conv = a.in[5];
    const int lane = f_lane, c0 = lane * 16, h = lane >> 3, s = t % SEQL;
    float l0 = lse[(size_t)t * NH + h], l1 = lse[((size_t)NTOK + t) * NH + h], l2 = lse[((size_t)2 * NTOK + t) * NH + h];
    const float lm = fmaxf(l0, fmaxf(l1, l2)); float w0 = __builtin_amdgcn_exp2f(l0 - lm), w1 = __builtin_amdgcn_exp2f(l1 - lm), w2 = __builtin_amdgcn_exp2f(l2 - lm);
    const float wi = 1.0f / (w0 + w1 + w2); w0 *= wi; w1 *= wi; w2 *= wi;
    float av[16], cv[16];
    {
        const u32x4 a0 = *(const GAS u32x4*)(og + (size_t)t * AW + c0), a1 = *(const GAS u32x4*)(og + (size_t)t * AW + c0 + 8);
        const u32x4 b0 = *(const GAS u32x4*)(og + ((size_t)NTOK + t) * AW + c0), b1 = *(const GAS u32x4*)(og + ((size_t)NTOK + t) * AW + c0 + 8);
        const u32x4 d0 = *(const GAS u32x4*)(og + ((size_t)2 * NTOK + t) * AW + c0), d1 = *(const GAS u32x4*)(og + ((size_t)2 * NTOK + t) * AW + c0 + 8);
#pragma unroll
        for (int i = 0; i < 4; ++i) { av[2 * i] = w0 * bflo(a0[i]) + w1 * bflo(b0[i]) + w2 * bflo(d0[i]); av[2 * i + 1] = w0 * bfhi(a0[i]) + w1 * bfhi(b0[i]) + w2 * bfhi(d0[i]);
            av[8 + 2 * i] = w0 * bflo(a1[i]) + w1 * bflo(b1[i]) + w2 * bflo(d1[i]); av[8 + 2 * i + 1] = w0 * bfhi(a1[i]) + w1 * bfhi(b1[i]) + w2 * bfhi(d1[i]); }
    }
    {
        const bf16* Bg = proj + (size_t)3 * NTOK * AW; const bf16* Cg = proj + (size_t)4 * NTOK * AW; const bf16* Hg = proj + (size_t)5 * NTOK * AW;
#pragma unroll
        for (int i = 0; i < 16; ++i) cv[i] = 0.f;
#pragma unroll
        for (int tap = 0; tap < 3; ++tap) { const int back = 2 - tap;
            if (s - back >= 0) { const size_t off = (size_t)(t - back) * AW + c0;
                const u32x4 cA = *(const GAS u32x4*)(Cg + off), cB = *(const GAS u32x4*)(Cg + off + 8), hA = *(const GAS u32x4*)(Hg + off), hB = *(const GAS u32x4*)(Hg + off + 8);
                const f32x4 wv0 = *(const GAS f32x4*)(conv_w + tap * AW + c0), wv1 = *(const GAS f32x4*)(conv_w + tap * AW + c0 + 4), wv2 = *(const GAS f32x4*)(conv_w + tap * AW + c0 + 8), wv3 = *(const GAS f32x4*)(conv_w + tap * AW + c0 + 12);
                const float wv[16] = {wv0.x, wv0.y, wv0.z, wv0.w, wv1.x, wv1.y, wv1.z, wv1.w, wv2.x, wv2.y, wv2.z, wv2.w, wv3.x, wv3.y, wv3.z, wv3.w};
#pragma unroll
                for (int i = 0; i < 4; ++i) { cv[2 * i] += wv[2 * i] * bflo(cA[i]) * bflo(hA[i]); cv[2 * i + 1] += wv[2 * i + 1] * bfhi(cA[i]) * bfhi(hA[i]);
                    cv[8 + 2 * i] += wv[8 + 2 * i] * bflo(cB[i]) * bflo(hB[i]); cv[8 + 2 * i + 1] += wv[8 + 2 * i + 1] * bfhi(cB[i]) * bfhi(hB[i]); } } }
        const u32x4 bA = *(const GAS u32x4*)(Bg + (size_t)t * AW + c0), bB = *(const GAS u32x4*)(Bg + (size_t)t * AW + c0 + 8);
#pragma unroll
        for (int i = 0; i < 4; ++i) { cv[2 * i] *= bflo(bA[i]); cv[2 * i + 1] *= bfhi(bA[i]); cv[8 + 2 * i] *= bflo(bB[i]); cv[8 + 2 * i + 1] *= bfhi(bB[i]); }
    }
    float sa = 0.f, sc = 0.f;
#pragma unroll
    for (int i = 0; i < 16; ++i) { sa += av[i] * av[i]; sc += cv[i] * cv[i]; }
    sa = wave_sum(sa); sc = wave_sum(sc);
    const float ra = __builtin_amdgcn_rsqf(sa * (1.0f / 1024.f) + RMS_EPS), rc = __builtin_amdgcn_rsqf(sc * (1.0f / 1024.f) + RMS_EPS);
    u32x4 oa0, oa1, oc0, oc1;
    {
        const f32x4 g0 = *(const GAS f32x4*)(g_attn + c0), g1 = *(const GAS f32x4*)(g_attn + c0 + 4), g2 = *(const GAS f32x4*)(g_attn + c0 + 8), g3 = *(const GAS f32x4*)(g_attn + c0 + 12);
        oa0.x = pk2(av[0] * ra * g0.x, av[1] * ra * g0.y); oa0.y = pk2(av[2] * ra * g0.z, av[3] * ra * g0.w); oa0.z = pk2(av[4] * ra * g1.x, av[5] * ra * g1.y); oa0.w = pk2(av[6] * ra * g1.z, av[7] * ra * g1.w);
        oa1.x = pk2(av[8] * ra * g2.x, av[9] * ra * g2.y); oa1.y = pk2(av[10] * ra * g2.z, av[11] * ra * g2.w); oa1.z = pk2(av[12] * ra * g3.x, av[13] * ra * g3.y); oa1.w = pk2(av[14] * ra * g3.z, av[15] * ra * g3.w);
        const f32x4 k0 = *(const GAS f32x4*)(g_conv + c0), k1 = *(const GAS f32x4*)(g_conv + c0 + 4), k2 = *(const GAS f32x4*)(g_conv + c0 + 8), k3 = *(const GAS f32x4*)(g_conv + c0 + 12);
        oc0.x = pk2(cv[0] * rc * k0.x, cv[1] * rc * k0.y); oc0.y = pk2(cv[2] * rc * k0.z, cv[3] * rc * k0.w); oc0.z = pk2(cv[4] * rc * k1.x, cv[5] * rc * k1.y); oc0.w = pk2(cv[6] * rc * k1.z, cv[7] * rc * k1.w);
        oc1.x = pk2(cv[8] * rc * k2.x, cv[9] * rc * k2.y); oc1.y = pk2(cv[10] * rc * k2.z, cv[11] * rc * k2.w); oc1.z = pk2(cv[12] * rc * k3.x, cv[13] * rc * k3.y); oc1.w = pk2(cv[14] * rc * k3.z, cv[15] * rc * k3.w);
    }
    bf16* mrow = mixed + (size_t)t * DM + c0;
    *(GAS u32x4*)(mrow) = oa0; *(GAS u32x4*)(mrow + 8) = oa1; *(GAS u32x4*)(mrow + AW) = oc0; *(GAS u32x4*)(mrow + AW + 8) = oc1;
}

__device__ __forceinline__ void route_wg(Frame& F, const Args& a, int wt) {
    const int f_lane = F_LANE(F), f_tid = F.wave * 64 + f_lane; (void)f_tid;
    const float* x2 = (const float*)(F.ws + WS_X1); const bf16* Wr = (const bf16*)(F.ws + WS_WR); const float* rbias = a.in[15];
    unsigned char* x2q = (unsigned char*)(F.ws + WS_X2Q);
    float* gates = (float*)(F.ws + WS_GATES); int* ltok = (int*)(F.ws + WS_LTOK); int* epos = (int*)(F.ws + WS_LSLOT);
    const int lane = f_lane, fr = lane & 15, fq = lane >> 4, w = F.wave, t0 = wt * 64 + 16 * (w & 3);
    LAS float* part = (LAS float*)(F.lds);
    LAS unsigned* lc = (LAS unsigned*)(F.lds + TAB_OFF);
    LAS pg8::f32x2* srow = (LAS pg8::f32x2*)(F.lds + TAB_OFF + 512);
    LAS float* gbt = (LAS float*)(F.lds + TAB_OFF + 1024);
    if (f_tid < 128) lc[f_tid] = 0u;
    { LAS f32x4* gb4 = (LAS f32x4*)gbt; gb4[f_tid] = *(const GAS f32x4*)(a.in[12] + 4 * f_tid); gb4[512 + f_tid] = *(const GAS f32x4*)(a.in[13] + 4 * f_tid); }
    if (f_tid < 64) { const f32x4* sp = (const f32x4*)((const pg8::f32x2*)(F.ws + WS_ST2) + (size_t)(wt * 64 + f_tid) * 32); f32x4 p[16]; float ms = 0.f;
#pragma unroll
        for (int i = 0; i < 16; ++i) { p[i] = *(const GAS f32x4*)(sp + i); ms += p[i].x + p[i].z; }
        const float mean = ms * (1.0f / 32.0f); float q = 0.f;
#pragma unroll
        for (int i = 0; i < 16; ++i) { const float d0 = p[i].x - mean, d1 = p[i].z - mean; q += (p[i].y + p[i].w) + 64.0f * (d0 * d0 + d1 * d1); }
        srow[f_tid] = (pg8::f32x2){mean, 1.0f / sqrtf(q * (1.0f / DM) + LN_EPS)}; }
    __syncthreads();
    {
        LAS const float* gl = gbt + w * 256 + 16 * fq; LAS const float* bl = gl + DM;
        const unsigned loff = (unsigned)(fr * DM + w * 256 + 16 * fq);
        const char* xu = (const char*)(x2 + (size_t)(wt * 64) * DM); unsigned char* qu = x2q + (size_t)(wt * 64) * DM; const char* wu = (const char*)Wr;
#define RT_X(g, c) (*(const GAS f32x4*)(xu + ((size_t)(16 * (g)) * DM + (c)) * 4 + (size_t)(loff * 4u)))
#define RT_W(T, c, lo) (*(const GAS bf16x8*)(wu + ((size_t)(16 * (T) + (lo) * NE) * DM + (c)) * 2 + (size_t)(loff * 2u)))
        f32x4 acc[4][4];
#pragma unroll
        for (int g = 0; g < 4; ++g)
#pragma unroll
            for (int T = 0; T < 4; ++T) acc[g][T] = (f32x4){0.f, 0.f, 0.f, 0.f};
        f32x4 xn[4][2];
#pragma unroll
        for (int g = 0; g < 4; ++g) { xn[g][0] = RT_X(g, 0); xn[g][1] = RT_X(g, 4); }
#pragma unroll 1
        for (int p = 0; p < 4; ++p) {
            unsigned qd[4][4];
#pragma unroll
            for (int b = 0; b < 2; ++b) { const int co = 64 * p + 8 * b; const int cn = b == 0 ? co + 8 : (p < 3 ? co + 56 : co);
                f32x4 xc[4][2];
#pragma unroll
                for (int g = 0; g < 4; ++g) { xc[g][0] = xn[g][0]; xc[g][1] = xn[g][1]; }
#pragma unroll
                for (int g = 0; g < 4; ++g) { xn[g][0] = RT_X(g, cn); xn[g][1] = RT_X(g, cn + 4); }
                bf16x8 wh[4], wl[4];
#pragma unroll
                for (int T = 0; T < 4; ++T) { wh[T] = RT_W(T, co, 0); wl[T] = RT_W(T, co, 1); }
                const f32x4 ga = *(LAS const f32x4*)(gl + co), gb = *(LAS const f32x4*)(gl + co + 4), ba = *(LAS const f32x4*)(bl + co), bb = *(LAS const f32x4*)(bl + co + 4);
#pragma unroll
                for (int g = 0; g < 4; ++g) { const pg8::f32x2 sr = srow[16 * g + fr];
                    const f32x4 na = (xc[g][0] - sr.x) * sr.y * ga + ba, nb = (xc[g][1] - sr.x) * sr.y * gb + bb;
                    const float xv[8] = {na.x, na.y, na.z, na.w, nb.x, nb.y, nb.z, nb.w};
                    qd[g][2 * b] = pg8::pk4_fp8(xv[0], xv[1], xv[2], xv[3]); qd[g][2 * b + 1] = pg8::pk4_fp8(xv[4], xv[5], xv[6], xv[7]);
                    u32x4 hw, lw;
#pragma unroll
                    for (int i = 0; i < 4; ++i) { const unsigned h0 = f2bf(xv[2 * i]), h1 = f2bf(xv[2 * i + 1]); hw[i] = h0 | (h1 << 16);
                        lw[i] = pk2(xv[2 * i] - __builtin_bit_cast(float, h0 << 16), xv[2 * i + 1] - __builtin_bit_cast(float, h1 << 16)); }
                    const bf16x8 xh = __builtin_bit_cast(bf16x8, hw), xl = __builtin_bit_cast(bf16x8, lw);
#pragma unroll
                    for (int T = 0; T < 4; ++T) {
                        acc[g][T] = __builtin_amdgcn_mfma_f32_16x16x32_bf16(wh[T], xh, acc[g][T], 0, 0, 0);
                        acc[g][T] = __builtin_amdgcn_mfma_f32_16x16x32_bf16(wh[T], xl, acc[g][T], 0, 0, 0);
                        acc[g][T] = __builtin_amdgcn_mfma_f32_16x16x32_bf16(wl[T], xh, acc[g][T], 0, 0, 0); } }
                asm volatile("" ::: "memory");
            }
#pragma unroll
            for (int g = 0; g < 4; ++g) *(GAS u32x4*)(qu + ((size_t)(16 * g) * DM + 64 * p) + (size_t)loff) = (u32x4){qd[g][0], qd[g][1], qd[g][2], qd[g][3]};
        }
#undef RT_X
#undef RT_W
#pragma unroll
        for (int g = 0; g < 4; ++g)
#pragma unroll
            for (int T = 0; T < 4; ++T) *(LAS f32x4*)(part + (((w * 4 + g) * 4 + T) * 64 + lane) * 4) = acc[g][T];
    }
    __syncthreads();
    int myidx[2] = {0, 0}; float mygate[2] = {0.f, 0.f}; unsigned mypos[2] = {0u, 0u};
    if (w < 4) {
        float sc[4][4], ch[4][4];
#pragma unroll
        for (int T = 0; T < 4; ++T) { f32x4 z = (f32x4){0.f, 0.f, 0.f, 0.f};
#pragma unroll
            for (int k = 0; k < 8; ++k) z += *(const LAS f32x4*)(part + (((k * 4 + w) * 4 + T) * 64 + lane) * 4);
            const f32x4 bv = *(const GAS f32x4*)(rbias + 16 * T + 4 * fq);
#pragma unroll
            for (int j = 0; j < 4; ++j) { sc[T][j] = __builtin_amdgcn_rcpf(1.0f + __builtin_amdgcn_exp2f(-1.44269504f * z[j])); ch[T][j] = sc[T][j] + bv[j]; } }
        float gsc[8];
#pragma unroll
        for (int T = 0; T < 4; ++T) {
            float a1 = fmaxf(ch[T][0], ch[T][1]), a2 = fminf(ch[T][0], ch[T][1]); const float c1 = fmaxf(ch[T][2], ch[T][3]), c2 = fminf(ch[T][2], ch[T][3]);
            float m1 = fmaxf(a1, c1), m2 = fmaxf(fminf(a1, c1), fmaxf(a2, c2));
            const float b1 = __shfl_xor(m1, 16), b2 = __shfl_xor(m2, 16);
            const float g1 = fmaxf(m1, b1), g2 = fmaxf(fminf(m1, b1), fmaxf(m2, b2)); const float gs = g1 + g2;
            const float og = __shfl_xor(gs, 32);
            gsc[2 * T] = (fq >> 1) ? og : gs; gsc[2 * T + 1] = (fq >> 1) ? gs : og;
        }
        unsigned gsel = 0u;
#pragma unroll
        for (int i = 0; i < 8; ++i) { int rank = 0;
#pragma unroll
            for (int j = 0; j < 8; ++j) rank += (gsc[j] > gsc[i] || (gsc[j] == gsc[i] && j < i)) ? 1 : 0;
            gsel |= (rank < 4 ? 1u : 0u) << i; }
        float cv[16]; float sv[16];
#pragma unroll
        for (int T = 0; T < 4; ++T)
#pragma unroll
            for (int j = 0; j < 4; ++j) { cv[T * 4 + j] = ((gsel >> (2 * T + (fq >> 1))) & 1u) ? ch[T][j] : -INFINITY; sv[T * 4 + j] = sc[T][j]; }
        float wsum = 0.f; float selsc[8]; int selid[8];
#pragma unroll
        for (int r = 0; r < 8; ++r) {
            float bv = -INFINITY, bs = 0.f; int bi = 64;
#pragma unroll
            for (int q = 0; q < 16; ++q) { const int e = 16 * (q >> 2) + 4 * fq + (q & 3); const bool better = cv[q] > bv; bv = better ? cv[q] : bv; bs = better ? sv[q] : bs; bi = better ? e : bi; }
#pragma unroll
            for (int o = 16; o <= 32; o <<= 1) { const float ov = __shfl_xor(bv, o), os = __shfl_xor(bs, o); const int oi = __shfl_xor(bi, o);
                const bool take = ov > bv || (ov == bv && oi < bi); bv = take ? ov : bv; bs = take ? os : bs; bi = take ? oi : bi; }
#pragma unroll
            for (int q = 0; q < 16; ++q) { const int e = 16 * (q >> 2) + 4 * fq + (q & 3); cv[q] = (e == bi) ? -INFINITY : cv[q]; }
            selsc[r] = bs; selid[r] = bi; wsum += bs;
        }
        const float wn = 2.5f / wsum;
#pragma unroll
        for (int r = 0; r < 8; ++r) if ((r >> 1) == fq) { myidx[r & 1] = selid[r]; mygate[r & 1] = selsc[r] * wn; }
#pragma unroll
        for (int i = 0; i < 2; ++i) mypos[i] = __hip_atomic_fetch_add(lc + myidx[i], 1u, __ATOMIC_RELAXED, __HIP_MEMORY_SCOPE_WORKGROUP);
    }
    __syncthreads();
    if (f_tid < NE) { const unsigned n = lc[f_tid]; unsigned base = 0u; if (n) base = __hip_atomic_fetch_add((unsigned*)(F.ctl + CW_CNT + 64 * f_tid), n, RLX_AGENT); lc[64 + f_tid] = base; }
    __syncthreads();
    if (w < 4) {
        const int t = t0 + fr;
#pragma unroll
        for (int i = 0; i < 2; ++i) { const int e = myidx[i], r = 2 * fq + i; const int pos = (int)(lc[64 + e] + mypos[i]);
            ltok[e * CAP + pos] = t; epos[t * 8 + r] = (e << 16) | pos; gates[t * 8 + r] = mygate[i]; }
    }
    __syncthreads();
}

struct GroupOrder {
    volatile LAS unsigned* MISC; const char* Abase; const char* Bbase; size_t Bstride; int K; int nmine; bool gather; int lda, ldb;
    __device__ __forceinline__ bool next(int i, pg8::Unit& u) const {
        if (i >= nmine) return false;
        const int pk = __builtin_amdgcn_readfirstlane((int)MISC[MW_UL + i]);
        const int e = pk >> 16, rt = (pk >> 4) & 0xfff, pn = pk & 15;
        u.pm = rt; u.pn = pn; u.e = e; u.slot = i;
        u.B = Bbase + (size_t)e * Bstride + (size_t)pn * 256 * K * 2;
        const int rb = __builtin_amdgcn_readfirstlane((int)MISC[MW_RB + e]);
        u.A = gather ? Abase : Abase + ((size_t)rb + (size_t)rt * 256) * K * 2;
        return true;
    }
};
__device__ __forceinline__ int group_setup(Frame& F, int npn, const int* list, int padfill, int shbase) {
    const int f_lane = F_LANE(F), f_tid = F.wave * 64 + f_lane; (void)f_tid;
    volatile LAS unsigned* M = F.MISC; LAS int* tab = (LAS int*)(F.lds + TAB_OFF);
    __syncthreads();
    if (f_tid < NEX) { const int c = (f_tid < NE) ? (int)__hip_atomic_load(F.ctl + CW_CNT + 64 * f_tid, RLX_AGENT) : NTOK; M[MW_CNT + f_tid] = (unsigned)c; }
    __syncthreads();
    if (f_tid == 0) { unsigned up = 0, rb = 0; for (int e = 0; e < NEX; ++e) { const unsigned nt = (M[MW_CNT + e] + 255u) >> 8; M[MW_PRE + e] = up; M[MW_RB + e] = rb; up += nt * (unsigned)npn; rb += nt * 256u; } M[MW_PRE + NEX] = up; }
    __syncthreads();
    const int nun = (int)M[MW_PRE + NEX];
    if (f_tid < MAXU) {
        const long L = (long)f_tid * F.G + (int)blockIdx.x; unsigned pk = 0xffffffffu;
        if (L < nun) { int wgid = (int)L; { const int q = nun / 8, r = nun % 8, xcd = wgid % 8, off = wgid / 8; wgid = (xcd < r ? xcd * (q + 1) : r * (q + 1) + (xcd - r) * q) + off; }
            int e = 0; for (int s = 64; s >= 1; s >>= 1) { if (e + s < NEX && (int)M[MW_PRE + e + s] <= wgid) e += s; }
            const int j = wgid - (int)M[MW_PRE + e]; pk = ((unsigned)e << 16) | ((unsigned)(j / npn) << 4) | (unsigned)(j % npn); }
        M[MW_UL + f_tid] = pk;
    }
    __syncthreads();
    int nm = 0; for (int i = 0; i < MAXU; ++i) if (M[MW_UL + i] != 0xffffffffu) nm = i + 1;
    if (list) for (int i = 0; i < nm; ++i) { const unsigned pk = M[MW_UL + i]; const int e = (int)(pk >> 16), rt = (int)((pk >> 4) & 0xfff), cnt = (int)M[MW_CNT + e];
        if (f_tid < 256) { const int r = rt * 256 + f_tid; int v = padfill; if (r < cnt) v = (e < NE) ? list[(size_t)e * CAP + r] : shbase + r; tab[i * 256 + f_tid] = v; } }
    __syncthreads();
    return nm;
}

__device__ __forceinline__ void rowbase_setup(Frame& F) {
    const int tid = F.wave * 64 + F_LANE(F); volatile LAS unsigned* M = F.MISC;
    __syncthreads();
    if (tid < NEX) { const int c = (tid < NE) ? (int)__hip_atomic_load(F.ctl + CW_CNT + 64 * tid, RLX_AGENT) : NTOK; M[MW_CNT + tid] = (unsigned)c; }
    __syncthreads();
    if (tid == 0) { unsigned rb = 0; for (int e = 0; e < NEX; ++e) { M[MW_RB + e] = rb; rb += ((M[MW_CNT + e] + 255u) >> 8) * 256u; } }
    __syncthreads();
}
__device__ __forceinline__ void final_row(Frame& F, const Args& a, int t) {
    const int f_lane = F_LANE(F), f_tid = F.wave * 64 + f_lane; (void)f_tid;
    const float* X2 = (const float*)(F.ws + WS_X1);
    const unsigned char* Y = (const unsigned char*)(F.ws + WS_Y); const float* gates = (const float*)(F.ws + WS_GATES);
    const float* g = a.in[22]; const float* bta = a.in[23]; float* out = a.out + (size_t)t * DM;
    const int lane = f_lane;
    float v[4][8];
    float mu2, rs2;
    { pg8::f32x2 pr = (pg8::f32x2){0.f, 0.f}; if (lane < 32) pr = *((const GAS pg8::f32x2*)(F.ws + WS_ST2) + (size_t)t * 32 + lane);
      mu2 = wave_sum(pr.x) * (1.0f / 32.0f); const float d = pr.x - mu2; const float q = wave_sum(lane < 32 ? pr.y + 64.0f * d * d : 0.f); rs2 = 1.0f / sqrtf(q * (1.0f / DM) + LN_EPS); }
    const float* g2 = a.in[12]; const float* b2 = a.in[13]; const float ar = ALPHA * rs2;
#pragma unroll
    for (int j = 0; j < 4; ++j) { const int c = 512 * j + 8 * lane; const f32x4 p0 = *(const GAS f32x4*)(X2 + (size_t)t * DM + c), p1 = *(const GAS f32x4*)(X2 + (size_t)t * DM + c + 4);
        const f32x4 g0 = *(const GAS f32x4*)(g2 + c), g1 = *(const GAS f32x4*)(g2 + c + 4), b0 = *(const GAS f32x4*)(b2 + c), b1 = *(const GAS f32x4*)(b2 + c + 4);
        const f32x4 n0 = (p0 - mu2) * ar * g0 + b0 * ALPHA, n1 = (p1 - mu2) * ar * g1 + b1 * ALPHA;
        v[j][0] = n0.x; v[j][1] = n0.y; v[j][2] = n0.z; v[j][3] = n0.w; v[j][4] = n1.x; v[j][5] = n1.y; v[j][6] = n1.z; v[j][7] = n1.w; }
    const f32x4 gk0 = *(const GAS f32x4*)(gates + t * 8), gk1 = *(const GAS f32x4*)(gates + t * 8 + 4);
    const int* epos = (const int*)(F.ws + WS_LSLOT);
    const u32x4 ep0 = *(const GAS u32x4*)(epos + t * 8), ep1 = *(const GAS u32x4*)(epos + t * 8 + 4);
    LAS const int* rbt = (LAS const int*)(F.lds + MISC_OFF + 4 * MW_RB);
#pragma unroll
    for (int k = 0; k < 9; ++k) { const unsigned epk = k == 0 ? ep0.x : k == 1 ? ep0.y : k == 2 ? ep0.z : k == 3 ? ep0.w : k == 4 ? ep1.x : k == 5 ? ep1.y : k == 6 ? ep1.z : ep1.w;
        const int yrow = (k < 8) ? rbt[epk >> 16] + (int)(epk & 0xffffu) : rbt[NE] + t;
        const unsigned char* yr = Y + (size_t)yrow * DM + 8 * lane;
        const float gkk = k == 0 ? gk0.x : k == 1 ? gk0.y : k == 2 ? gk0.z : k == 3 ? gk0.w : k == 4 ? gk1.x : k == 5 ? gk1.y : k == 6 ? gk1.z : k == 7 ? gk1.w : 1.0f;
#pragma unroll
        for (int j = 0; j < 4; ++j) { const u32x2 w = __builtin_nontemporal_load((const GAS u32x2*)(yr + 512 * j));
            typedef float f2_t __attribute__((ext_vector_type(2)));
            const f2_t a0 = __builtin_amdgcn_cvt_pk_f32_fp8((int)w.x, false), a1 = __builtin_amdgcn_cvt_pk_f32_fp8((int)w.x, true), a2 = __builtin_amdgcn_cvt_pk_f32_fp8((int)w.y, false), a3 = __builtin_amdgcn_cvt_pk_f32_fp8((int)w.y, true);
            v[j][0] += gkk * a0.x; v[j][1] += gkk * a0.y; v[j][2] += gkk * a1.x; v[j][3] += gkk * a1.y; v[j][4] += gkk * a2.x; v[j][5] += gkk * a2.y; v[j][6] += gkk * a3.x; v[j][7] += gkk * a3.y; } }
    float s = 0.f;
#pragma unroll
    for (int j = 0; j < 4; ++j)
#pragma unroll
        for (int i = 0; i < 8; ++i) s += v[j][i];
    const float mean = wave_sum(s) * (1.f / DM); float s2 = 0.f;
#pragma unroll
    for (int j = 0; j < 4; ++j)
#pragma unroll
        for (int i = 0; i < 8; ++i) { v[j][i] -= mean; s2 += v[j][i] * v[j][i]; }
    const float rstd = __builtin_amdgcn_rsqf(wave_sum(s2) * (1.f / DM) + LN_EPS);
#pragma unroll
    for (int j = 0; j < 4; ++j) { const int c = 512 * j + 8 * lane;
        const f32x4 g0 = *(const GAS f32x4*)(g + c), g1 = *(const GAS f32x4*)(g + c + 4), b0 = *(const GAS f32x4*)(bta + c), b1 = *(const GAS f32x4*)(bta + c + 4);
        f32x4 o0, o1; o0.x = v[j][0] * rstd * g0.x + b0.x; o0.y = v[j][1] * rstd * g0.y + b0.y; o0.z = v[j][2] * rstd * g0.z + b0.z; o0.w = v[j][3] * rstd * g0.w + b0.w;
        o1.x = v[j][4] * rstd * g1.x + b1.x; o1.y = v[j][5] * rstd * g1.y + b1.y; o1.z = v[j][6] * rstd * g1.z + b1.z; o1.w = v[j][7] * rstd * g1.w + b1.w;
        __builtin_nontemporal_store(o0, (GAS f32x4*)(out + c)); __builtin_nontemporal_store(o1, (GAS f32x4*)(out + c + 4)); }
}

__device__ __forceinline__ void ph_inproj(Frame& F, LAS const int* tab, int G, int c) {
    pg8::DenseOrder S; S.init(F.ws + WS_XB, F.ws + WS_WIN, NTOK, INC, DM, G, c);
    pg8::EpiBf16 E{(bf16*)(F.ws + WS_PROJ), AW, AW, (size_t)NTOK * AW, QSCALE};
    pg8::gemm_phase<pg8::EpiBf16, pg8::DenseOrder, false>(F.lds + RING_OFF, DM, S, E, tab, F.wave);
}
__device__ __forceinline__ void ph_kvm(Frame& F, LAS const int* tab) {
    pg8::DenseOrder S; S.init(F.ws + WS_MB, F.ws + WS_WKV, NB * MEML, 2 * DM, DM, F.G, (int)blockIdx.x);
    pg8::EpiBf16 E{(bf16*)(F.ws + WS_KVM), 2 * DM, 0, 0, 1.0f};
    pg8::gemm_phase<pg8::EpiBf16, pg8::DenseOrder, false>(F.lds + RING_OFF, DM, S, E, tab, F.wave);
    __syncthreads();
}
struct XprepOrder {
    const char* KVm; const char* W; int type, c, lda, ldb;
    __device__ __forceinline__ bool next(int i, pg8::Unit& u) const {
        if (i != 0) return false;
        if (type == 0) { if (c >= 128) return false; const int b = c >> 5, h = (c >> 3) & 3, pn = c & 7;
            u.pm = b * 4 + h; u.pn = pn; u.e = 0; u.slot = 0; u.A = KVm + ((size_t)(b * MEML) * (2 * DM) + h * MHD) * 2; u.B = W + ((size_t)(pn * 256) * DM + h * MHD) * 2; return true; }
        if (c < 128) return false; const int L = c - 128, b = L >> 5, pm = (L >> 2) & 7, h = L & 3;
        u.pm = pm; u.pn = h; u.e = b; u.slot = 0; u.A = W + ((size_t)(pm * 256) * DM + h * MHD) * 2; u.B = KVm + ((size_t)(b * MEML) * (2 * DM) + DM + h * MHD) * 2; return true;
    }
};
__device__ __forceinline__ void ph_xprep(Frame& F, LAS const int* tab, const float* g1, const float* b1) {
    { XprepOrder S{(const char*)(F.ws + WS_KVM), (const char*)(F.ws + WS_WQ), 0, (int)blockIdx.x, 2 * DM, DM};
      pg8::EpiBt1 E{(bf16*)(F.ws + WS_BT1), g1, b1, (pg8::f32x2*)(F.ws + WS_S12), MQSCALE};
      pg8::gemm_phase<pg8::EpiBt1, XprepOrder, false>(F.lds + RING_OFF, MHD, S, E, tab, F.wave); }
    { XprepOrder S{(const char*)(F.ws + WS_KVM), (const char*)(F.ws + WS_WO), 1, (int)blockIdx.x, DM, 2 * DM};
      pg8::EpiBf16 E{(bf16*)(F.ws + WS_BT2), 1024, 0, 0, 1.0f, (size_t)DM * 1024};
      pg8::gemm_phase<pg8::EpiBf16, XprepOrder, false>(F.lds + RING_OFF, MHD, S, E, tab, F.wave); }
    __syncthreads();
}
template <bool LN0, bool LN1>
__device__ __forceinline__ void reduce_partials(Frame& F, const pg8::f32x2* p0, LAS pg8::f32x2* out0, const pg8::f32x2* p1, LAS pg8::f32x2* out1) {
    const int tid = F.wave * 64 + F_LANE(F), h = tid >> 8, r = tid & 255;
    const pg8::f32x2* p = h ? p1 : p0; LAS pg8::f32x2* out = h ? out1 : out0; const bool ln = h ? LN1 : LN0;
    if (p) { const f32x4* sp = (const f32x4*)(p + (size_t)r * 32); f32x4 v[16]; float sx = 0.f, sy = 0.f;
#pragma unroll
        for (int i = 0; i < 16; ++i) { v[i] = *(const GAS f32x4*)(sp + i); sx += v[i].x + v[i].z; sy += v[i].y + v[i].w; }
        if (ln) { const float mean = sx * (1.0f / 32.0f); float q = sy;
#pragma unroll
            for (int i = 0; i < 16; ++i) { const float d0 = v[i].x - mean, d1 = v[i].z - mean; q += 64.0f * (d0 * d0 + d1 * d1); }
            out[r] = (pg8::f32x2){mean, 1.0f / sqrtf(q * (1.0f / DM) + LN_EPS)}; }
        else out[r] = (pg8::f32x2){sx, sy}; }
}
struct ChunkOrder {
    pg8::DenseOrder S; int base, n, lda, ldb;
    __device__ __forceinline__ bool next(int j, pg8::Unit& u) const { if (j >= n) return false; const bool ok = S.next(base + j, u); u.slot = j; return ok; }
};
__device__ __forceinline__ void ph_xscore(Frame& F, LAS const int* tab) {
    pg8::DenseOrder S; S.init(F.ws + WS_X1B, F.ws + WS_BT1, NTOK, 1024, DM, F.G, (int)blockIdx.x); S.b_panels = 16; S.b_stride = (size_t)1024 * DM * 2;
    LAS pg8::f32x2* rt = (LAS pg8::f32x2*)(F.lds + TAB_OFF + 8192); LAS pg8::f32x2* ct = (LAS pg8::f32x2*)(F.lds + TAB_OFF + 10240);
#pragma unroll 1
    for (int i = 0; ; ++i) { pg8::Unit u; if (!S.next(i, u)) break;
        reduce_partials<true, false>(F, (const pg8::f32x2*)(F.ws + WS_ST1) + (size_t)u.pm * 256 * 32, rt, (const pg8::f32x2*)(F.ws + WS_S12) + (size_t)((u.pm / 16) * 1024 + u.pn * 256) * 32, ct);
        __syncthreads();
        ChunkOrder C{S, i, 1, S.lda, S.ldb};
        pg8::EpiSoftmax E{(bf16*)(F.ws + WS_P), 1024, (LAS pg8::f32x2*)(F.lds + TAB_OFF), rt, ct};
        pg8::gemm_phase<pg8::EpiSoftmax, ChunkOrder, false>(F.lds + RING_OFF, DM, C, E, tab, F.wave);
        __syncthreads(); }
}
__device__ __forceinline__ void ph_outproj_stats(Frame& F, LAS const int* tab) {
    pg8::DenseOrder S; S.init(F.ws + WS_MIXED, F.ws + WS_WOUT, NTOK, DM, DM, F.G, (int)blockIdx.x);
    pg8::EpiResStats<false, true> E{(const bf16*)(F.ws + WS_XB), ALPHA, nullptr, (bf16*)(F.ws + WS_X1B), (pg8::f32x2*)(F.ws + WS_ST1), nullptr, nullptr, nullptr};
    pg8::gemm_phase<pg8::EpiResStats<false, true>, pg8::DenseOrder, false>(F.lds + RING_OFF, DM, S, E, tab, F.wave);
    __syncthreads();
}
__device__ __forceinline__ void ph_oproj_stats(Frame& F, LAS const int* tab, const float* g1, const float* b1) {
    pg8::DenseOrder S; S.init(F.ws + WS_P, F.ws + WS_BT2, NTOK, DM, 1024, F.G, (int)blockIdx.x); S.b_panels = 16; S.b_stride = (size_t)DM * 1024 * 2;
    LAS pg8::f32x2* rs = (LAS pg8::f32x2*)(F.lds + TAB_OFF);
#pragma unroll 1
    for (int base = 0; ; base += 2) { pg8::Unit u0, u1; if (!S.next(base, u0)) break; const bool two = S.next(base + 1, u1);
        reduce_partials<true, true>(F, (const pg8::f32x2*)(F.ws + WS_ST1) + (size_t)u0.pm * 256 * 32, rs, two ? (const pg8::f32x2*)(F.ws + WS_ST1) + (size_t)u1.pm * 256 * 32 : nullptr, rs + 256);
        __syncthreads();
        ChunkOrder C{S, base, two ? 2 : 1, S.lda, S.ldb};
        pg8::EpiResStats<true, false> E{(const bf16*)(F.ws + WS_X1B), ALPHA, (float*)(F.ws + WS_X1), nullptr, (pg8::f32x2*)(F.ws + WS_ST2), rs, g1, b1};
        pg8::gemm_phase<pg8::EpiResStats<true, false>, ChunkOrder, false>(F.lds + RING_OFF, 1024, C, E, tab, F.wave);
        __syncthreads(); }
}
__device__ __forceinline__ void ph_moe1(Frame& F, LAS const int* tab, int dry) {
    GroupOrder S; S.MISC = F.MISC; S.Abase = (const char*)(F.ws + WS_X2Q); S.Bbase = (const char*)(F.ws + WS_WGU); S.Bstride = (size_t)1024 * DM; S.K = DM / 2; S.gather = true; S.lda = DM / 2; S.ldb = DM / 2;
    S.nmine = group_setup(F, 4, (const int*)(F.ws + WS_LTOK), 0, 0);
    pg8::EpiSwiGLU E{(unsigned char*)(F.ws + WS_H), (LAS const int*)(F.lds + MISC_OFF + 4 * MW_RB), WPOST, dry};
    int Kv = DM / 2; asm volatile("" : "+s"(Kv));
    pg8::gemm_phase<pg8::EpiSwiGLU, GroupOrder, true, true>(F.lds + RING_OFF, Kv, S, E, tab, F.wave);
}
__device__ __forceinline__ void ph_moe2(Frame& F, LAS const int* tab, int dry) {
    GroupOrder S; S.MISC = F.MISC; S.Abase = (const char*)(F.ws + WS_H); S.Bbase = (const char*)(F.ws + WS_WD); S.Bstride = (size_t)DM * FF; S.K = FF / 2; S.gather = false; S.lda = FF / 2; S.ldb = FF / 2;
    S.nmine = group_setup(F, 8, nullptr, -1, 0);
    pg8::EpiDown E{(unsigned char*)(F.ws + WS_Y), (LAS const int*)(F.lds + MISC_OFF + 4 * MW_RB)}; (void)dry; static_assert(WPOST == pg8::EpiDown::ws, "expert weight prescale");
    int Kv = FF / 2; asm volatile("" : "+s"(Kv));
    pg8::gemm_phase<pg8::EpiDown, GroupOrder, false, true>(F.lds + RING_OFF, Kv, S, E, tab, F.wave);
}

enum { PH_PRO = 0, PH_INPROJ, PH_DATTN, PH_MIX, PH_OUTPROJ, PH_LN1, PH_QPROJ, PH_XATTN, PH_OPROJ, PH_LN2, PH_ROUTE, PH_MOE1, PH_MOE2, PH_FINAL, PH_END };
__global__ void __launch_bounds__(NWAVES * 64, 2) mk_fwd(Args args) {
    extern __shared__ __attribute__((aligned(16))) unsigned char lds_raw[];
    Frame F;
    F.lds = (LAS unsigned char*)lds_raw; F.MISC = (volatile LAS unsigned*)(F.lds + MISC_OFF);
    F.wave = __builtin_amdgcn_readfirstlane((int)threadIdx.x >> 6);
    F.G = gridDim.x; { const int bx = blockIdx.x; F.vcu = (F.G % 8 == 0) ? (bx % 8) * (F.G / 8) + bx / 8 : bx; }
    F.ws = args.ws; F.ctl = (gu32*)(args.ws + WS_CTL);
    for (int u = (int)threadIdx.x; u < MISC_BYTES / 4; u += NWAVES * 64) F.MISC[u] = 0u;
    __syncthreads();
    XcdBarrier bar; bar.bar = (unsigned*)(F.ctl + CW_BAR); bar.x = 0; bar.st = nullptr; bar.wave = F.wave;
    if (args.use_bar) bar = xcd_barrier_post((unsigned*)(F.ctl + CW_BAR), F.MISC, F.wave);
    const int lo = args.ph_lo, hi = args.ph_hi;
#define IN(k) (lo <= (k) && (k) < hi)
#define SEAM(k) do { if (IN(k) && IN((k) + 1)) xcd_barrier(bar); } while (0)
#ifndef REP_MASK
#define REP_MASK 0
#endif
#define REPS(k) for (int _r = 0; _r <= ((REP_MASK >> (k)) & 1); ++_r)
#define REPBAR(k) do { if (_r < ((REP_MASK >> (k)) & 1)) xcd_barrier(bar); } while (0)
    const int gw = F.vcu * NWAVES + F.wave, NGW = F.G * NWAVES;
    LAS const int* tab = (LAS const int*)(F.lds + TAB_OFF);

    const bool fusedln = (F.G == 256);
    if (IN(PH_PRO)) { p0_prologue(F, args, 0, gw, NGW); if (!fusedln) p0_prologue(F, args, 1, gw, NGW); SEAM(PH_PRO); }
    if (IN(PH_INPROJ)) {
        const int bx = (int)blockIdx.x;
        if (fusedln) { if (((bx >> 3) & 3) == 3) { const int cr = (bx >> 5) * 8 + (bx & 7); p0_prologue(F, args, 1, cr * NWAVES + F.wave, 64 * NWAVES); __syncthreads(); }
                       else ph_inproj(F, tab, 192, (bx >> 5) * 24 + ((bx >> 3) & 3) * 8 + (bx & 7)); }
        else ph_inproj(F, tab, F.G, bx);
#if (REP_MASK >> 1) & 1
        xcd_barrier(bar); ph_inproj(F, tab, F.G, bx);
#endif
        SEAM(PH_INPROJ); }
    if (IN(PH_DATTN)) {
        constexpr int NU = NB * NH * 96;
        ph_kvm(F, tab);
        REPS(PH_DATTN) {
            if (F.G == 256) { const int bx = (int)blockIdx.x; if (bx < 64) dattn_phase(F, bx * DA_KVU, 1, bx * DA_KVU + DA_KVU); else dattn_phase(F, 64 * DA_KVU + bx - 64, 192, NU); }
            else dattn_phase(F, F.vcu, F.G, NU);
            REPBAR(PH_DATTN); }
        SEAM(PH_DATTN); }
    if (IN(PH_MIX)) { ph_xprep(F, tab, args.in[7], args.in[8]); REPS(PH_MIX) { for (int t = gw; t < NTOK; t += NGW) p3_token(F, args, t); REPBAR(PH_MIX); } SEAM(PH_MIX); }
    if (IN(PH_OUTPROJ)) { ph_outproj_stats(F, tab);
#if (REP_MASK >> 4) & 1
        xcd_barrier(bar); ph_outproj_stats(F, tab);
#endif
        SEAM(PH_OUTPROJ); }
    if (IN(PH_QPROJ)) { ph_xscore(F, tab);
#if (REP_MASK >> 6) & 1
        xcd_barrier(bar); ph_xscore(F, tab);
#endif
        SEAM(PH_QPROJ); }
    if (IN(PH_OPROJ)) {
        ph_oproj_stats(F, tab, args.in[7], args.in[8]);
#if (REP_MASK >> 8) & 1
        xcd_barrier(bar); ph_oproj_stats(F, tab, args.in[7], args.in[8]);
#endif
        SEAM(PH_OPROJ); }
    if (IN(PH_ROUTE)) {
#if (REP_MASK >> 10) & 1
        for (int wt = F.vcu; wt < NTOK / 64; wt += F.G) route_wg(F, args, wt);
        xcd_barrier(bar); if (blockIdx.x == 0 && (int)threadIdx.x < NE) __hip_atomic_store(F.ctl + CW_CNT + 64 * (int)threadIdx.x, 0u, RLX_AGENT); xcd_barrier(bar);
#endif
        for (int wt = F.vcu; wt < NTOK / 64; wt += F.G) route_wg(F, args, wt); SEAM(PH_ROUTE); }
    if (IN(PH_MOE1)) {
#if (REP_MASK >> 11) & 1
        ph_moe1(F, tab, 1); xcd_barrier(bar);
#endif
        ph_moe1(F, tab, 0);
        SEAM(PH_MOE1); }
    if (IN(PH_MOE2)) {
#if (REP_MASK >> 12) & 1
        ph_moe2(F, tab, 1); xcd_barrier(bar);
#endif
        ph_moe2(F, tab, 0); SEAM(PH_MOE2); }
    if (IN(PH_FINAL)) { rowbase_setup(F); REPS(PH_FINAL) { for (int t = gw; t < NTOK; t += NGW) final_row(F, args, t); REPBAR(PH_FINAL); } }
#undef IN
#undef SEAM
}

static int g_grid = 0;
inline bool mk_init() {
    if (g_grid == 0) {
        int dev = 0, cus = 0;
        if (hipGetDevice(&dev) != hipSuccess || hipDeviceGetAttribute(&cus, hipDeviceAttributeMultiprocessorCount, dev) != hipSuccess) { g_grid = -1; return false; }
        if (hipFuncSetAttribute((const void*)mk_fwd, hipFuncAttributeMaxDynamicSharedMemorySize, LDS_BYTES) != hipSuccess) { g_grid = -1; return false; }
        int per_cu = 0;
        if (hipOccupancyMaxActiveBlocksPerMultiprocessor(&per_cu, (const void*)mk_fwd, NWAVES * 64, LDS_BYTES) != hipSuccess || per_cu < 1) { fprintf(stderr, "kernel_launch: occupancy query admits %d workgroups per CU; nothing launched\n", per_cu); g_grid = -1; return false; }
        (void)hipGetLastError();
        g_grid = cus;
    }
    return g_grid > 0;
}
inline void mk_run(void* const* d_in, void* d_out, void* d_ws, hipStream_t stream, int lo, int hi, bool per_phase) {
    if (!mk_init()) return;
    Args a{};
    for (int i = 0; i < 24; ++i) a.in[i] = (const float*)d_in[i];
    a.out = (float*)d_out; a.ws = (unsigned char*)d_ws;
    if (per_phase) { for (int p = lo; p < hi; ++p) { a.ph_lo = p; a.ph_hi = p + 1; a.use_bar = 0; hipLaunchKernelGGL(mk_fwd, dim3(g_grid), dim3(NWAVES * 64), LDS_BYTES, stream, a); } }
    else { a.ph_lo = lo; a.ph_hi = hi; a.use_bar = 1; hipLaunchKernelGGL(mk_fwd, dim3(g_grid), dim3(NWAVES * 64), LDS_BYTES, stream, a); }
}
}
extern "C" void kernel_launch(void* const* d_in, const int* in_sizes, int n_in, void* d_out, int out_size, void* d_ws, size_t ws_size, hipStream_t stream) {
    (void)in_sizes; (void)n_in; (void)out_size; (void)ws_size;
    (void)hipMemsetAsync((char*)d_ws + mk::WS_CTL, 0, mk::CTL_ZERO_BYTES, stream);
    mk::mk_run(d_in, d_out, d_ws, stream, 0, mk::PH_END, false);
}
```
